# Optimizing an MI355X kernel written in HIP

```python
import math
import jax
import jax.numpy as jnp
from jax import lax

D_MODEL = 2048
BATCH = 4
SEQ = 2048
DEPTH = 4

GRID_W = 64
CTX_LEN = 256
N_EVEN = (DEPTH + 1) // 2
N_ODD = DEPTH // 2
EPS = 1e-6
N_DIR = 2

HEAD_DIM = 128
A_Q_HEADS = 12
A_KV_HEADS = 4
A_GROUP = A_Q_HEADS // A_KV_HEADS
A_WIDTH = A_Q_HEADS * HEAD_DIM
KV_WIDTH = A_KV_HEADS * HEAD_DIM
ROPE_THETA = 10000.0
ROPE_AXIS_DIM = HEAD_DIM // 2
Q_BLOCK = 128

B_GROUPS = 4
B_GROUP_DIM = 128
B_WIDTH = B_GROUPS * B_GROUP_DIM
CHUNK = 128

EVEN_IN = 2 * KV_WIDTH + A_WIDTH + 2 * B_WIDTH + A_WIDTH + B_WIDTH
EVEN_MIX = A_WIDTH + B_WIDTH
EVEN_SPLITS = (KV_WIDTH, 2 * KV_WIDTH, 2 * KV_WIDTH + A_WIDTH, 2 * KV_WIDTH + A_WIDTH + B_WIDTH, 2 * KV_WIDTH + A_WIDTH + 2 * B_WIDTH, 2 * KV_WIDTH + 2 * A_WIDTH + 2 * B_WIDTH)

C_WIDTH = 1024
C_GROUP_DIM = 16
C_GROUPS = C_WIDTH // C_GROUP_DIM
C_STATE = 64

D_WIDTH = 1024
D_BLOCKS = 8
D_BLOCK_DIM = D_WIDTH // D_BLOCKS
CONV_W = 4
CONV_PAD_LO = (CONV_W - 1) // 2
LRU_C = 8.0

ODD_IN = 2 * (C_WIDTH + D_WIDTH)
ODD_MIX = C_WIDTH + D_WIDTH
ODD_SPLITS = (C_WIDTH, C_WIDTH + D_WIDTH, 2 * C_WIDTH + D_WIDTH)

kernel_name = 'hybrid_diffusion_attn_sgu_s5_rglru'


def rms_norm(x, g):
    xf = x.astype(jnp.float32)
    y = xf * lax.rsqrt(jnp.mean(xf * xf, axis=-1, keepdims=True) + EPS)
    return (y * g.astype(jnp.float32)).astype(x.dtype)


def modulate(x, g, shift, scale):
    return rms_norm(x, g) * (1 + scale) + shift


def adaln(cond, w, b):
    m = jax.nn.silu(cond) @ w + b
    return jnp.split(m, 3, axis=-1)


def flip(t):
    return jnp.flip(t, axis=1)


def axial_rope_tables(rows):
    row = jnp.repeat(jnp.arange(rows), GRID_W).astype(jnp.float32)
    col = jnp.tile(jnp.arange(GRID_W), rows).astype(jnp.float32)
    inv = ROPE_THETA ** (-jnp.arange(0, ROPE_AXIS_DIM, 2, dtype=jnp.float32) / ROPE_AXIS_DIM)
    ang = jnp.concatenate([row[:, None] * inv, col[:, None] * inv], axis=-1)
    return jnp.cos(ang), jnp.sin(ang)


def apply_rope(x, cos, sin):
    xf = x.astype(jnp.float32).reshape(x.shape[:-1] + (HEAD_DIM // 2, 2))
    x0, x1 = xf[..., 0], xf[..., 1]
    cs, sn = cos[None, :, None, :], sin[None, :, None, :]
    out = jnp.stack([x0 * cs - x1 * sn, x0 * sn + x1 * cs], axis=-1)
    return out.reshape(x.shape).astype(x.dtype)


def heads(t, n):
    return t.reshape(t.shape[0], t.shape[1], n, HEAD_DIM)


def gqa_attend(q, k, v):
    s = jnp.einsum('bqkgd,bskd->bkgqs', q, k).astype(jnp.float32) * (HEAD_DIM ** -0.5)
    p = jax.nn.softmax(s, axis=-1).astype(v.dtype)
    return jnp.einsum('bkgqs,bskd->bqkgd', p, v)


def latent_attention(q_l, k_all, v_all):
    b, l = q_l.shape[:2]
    nb = l // Q_BLOCK
    qb = q_l.reshape(b, nb, Q_BLOCK, A_KV_HEADS, A_GROUP, HEAD_DIM).transpose(1, 0, 2, 3, 4, 5)
    out = lax.map(lambda qi: gqa_attend(qi, k_all, v_all), qb)
    return out.transpose(1, 0, 2, 3, 4, 5).reshape(b, l, A_WIDTH)


def chunk_mlp(u, v, norm_g, w_s, b_s):
    b, l = u.shape[:2]
    vn = rms_norm(v.reshape(b, l // CHUNK, CHUNK, B_GROUPS, B_GROUP_DIM), norm_g.reshape(B_GROUPS, B_GROUP_DIM))
    mixed = jnp.einsum('gpq,bnqgc->bnpgc', w_s, vn) + b_s.T[:, :, None]
    return u * mixed.reshape(b, l, B_WIDTH)


def even_mixer(h, hc, w_in, w_out, q_g, k_g, sgu_g, w_s, b_s, cos, sin, ctx_out):
    b, l = h.shape[:2]
    lc = hc.shape[1]
    k_l, v_l, q_l, bu_l, bv_l, ga_l, gb_l = jnp.split(h @ w_in, EVEN_SPLITS, axis=-1)
    q_l = apply_rope(rms_norm(heads(q_l, A_Q_HEADS), q_g), cos, sin)
    k_l = apply_rope(rms_norm(heads(k_l, A_KV_HEADS), k_g), cos, sin)
    v_l = heads(v_l, A_KV_HEADS)
    if ctx_out:
        k_c, v_c, q_c, bu_c, bv_c, ga_c, gb_c = jnp.split(hc @ w_in, EVEN_SPLITS, axis=-1)
    else:
        k_c, v_c = jnp.split(hc @ w_in[:, :2 * KV_WIDTH], 2, axis=-1)
    k_c = rms_norm(heads(k_c, A_KV_HEADS), k_g)
    v_c = heads(v_c, A_KV_HEADS)
    k_all = jnp.concatenate([k_c, k_l], axis=1)
    v_all = jnp.concatenate([v_c, v_l], axis=1)
    attn_l = latent_attention(q_l, k_all, v_all)
    sgu_l = chunk_mlp(bu_l, bv_l, sgu_g, w_s, b_s)
    mix_l = jnp.concatenate([attn_l * jax.nn.silu(ga_l), sgu_l * jax.nn.silu(gb_l)], axis=-1)
    out_l = mix_l @ w_out
    if not ctx_out:
        return out_l, None
    q_c = rms_norm(heads(q_c, A_Q_HEADS), q_g).reshape(b, lc, A_KV_HEADS, A_GROUP, HEAD_DIM)
    attn_c = gqa_attend(q_c, k_c, v_c).reshape(b, lc, A_WIDTH)
    sgu_c = chunk_mlp(bu_c, bv_c, sgu_g, w_s, b_s)
    mix_c = jnp.concatenate([attn_c * jax.nn.silu(ga_c), sgu_c * jax.nn.silu(gb_c)], axis=-1)
    return out_l, mix_c @ w_out


def linear_scan(a, b, h0=None):
    if h0 is not None:
        b = b.at[:, 0].add(a[:, 0] * h0)

    def combine(e1, e2):
        a1, b1 = e1
        a2, b2 = e2
        return a1 * a2, a2 * b1 + b2

    return lax.associative_scan(combine, (a, b), axis=1)[1]


def s5_direction(u_c, u_l, lam_re, lam_im, log_dt, b_re, b_im, c_re, c_im, ctx_out):
    lam = lax.complex(lam_re.astype(jnp.float32), lam_im.astype(jnp.float32))
    dt = jnp.exp(log_dt.astype(jnp.float32))[:, None]
    a_bar = jnp.exp(lam * dt)
    b_bar = ((a_bar - 1) / lam)[:, :, None] * lax.complex(b_re.astype(jnp.float32), b_im.astype(jnp.float32))
    c_mat = lax.complex(c_re.astype(jnp.float32), c_im.astype(jnp.float32))

    def drive(u):
        bu = jnp.einsum('blgp,gnp->blgn', u.astype(jnp.float32).astype(jnp.complex64), b_bar)
        return jnp.broadcast_to(a_bar, bu.shape), bu

    def readout(hs):
        return jnp.einsum('blgn,gpn->blgp', hs, c_mat).real

    a_c, bu_c = drive(u_c)
    h_c = linear_scan(a_c, bu_c)
    a_l, bu_l = drive(u_l)
    h_l = linear_scan(a_l, bu_l, h_c[:, -1])
    return (readout(h_c) if ctx_out else None), readout(h_l)


def s5_mixer(u_c, u_l, lam_re, lam_im, log_dt, b_re, b_im, c_re, c_im, d_skip, glu_w, glu_b, ctx_out):
    def grp(t):
        return t.reshape(t.shape[0], t.shape[1], C_GROUPS, C_GROUP_DIM)

    yc_f, yl_f = s5_direction(grp(u_c), grp(u_l), lam_re[0], lam_im[0], log_dt[0], b_re[0], b_im[0], c_re[0], c_im[0], ctx_out)
    yc_b, yl_b = s5_direction(grp(flip(u_c)), grp(flip(u_l)), lam_re[1], lam_im[1], log_dt[1], b_re[1], b_im[1], c_re[1], c_im[1], ctx_out)

    def finish(y_f, y_b, u):
        y = (y_f + flip(y_b)).reshape(u.shape).astype(u.dtype) + d_skip * u
        y = jax.nn.gelu(y)
        return y * jax.nn.sigmoid(y @ glu_w + glu_b)

    y_l = finish(yl_f, yl_b, u_l)
    return (finish(yc_f, yc_b, u_c) if ctx_out else None), y_l


def short_conv(x, w, b):
    l = x.shape[1]
    xp = jnp.pad(x, ((0, 0), (CONV_PAD_LO, CONV_W - 1 - CONV_PAD_LO), (0, 0)))
    return sum(xp[:, k:k + l] * w[k] for k in range(CONV_W)) + b


def rglru_direction(x_c, x_l, lam, wa, ba, wx, bx, ctx_out):
    def coeffs(xv):
        b, l = xv.shape[:2]
        xg = xv.reshape(b, l, D_BLOCKS, D_BLOCK_DIM)
        r = jax.nn.sigmoid(jnp.einsum('blhi,hij->blhj', xg, wa).reshape(b, l, D_WIDTH) + ba)
        i = jax.nn.sigmoid(jnp.einsum('blhi,hij->blhj', xg, wx).reshape(b, l, D_WIDTH) + bx)
        log_a = (-LRU_C * jax.nn.softplus(-lam) * r).astype(jnp.float32)
        mult = jnp.sqrt(-jnp.expm1(2 * log_a))
        return jnp.exp(log_a), mult * (i * xv).astype(jnp.float32)

    a_c, b_c = coeffs(x_c)
    h_c = linear_scan(a_c, b_c)
    a_l, b_l = coeffs(x_l)
    h_l = linear_scan(a_l, b_l, h_c[:, -1])
    return (h_c if ctx_out else None), h_l


def rglru_mixer(x_c, x_l, conv_w, conv_b, lam, wa, ba, wx, bx, ctx_out):
    x_c = short_conv(x_c, conv_w, conv_b)
    x_l = short_conv(x_l, conv_w, conv_b)
    hc_f, hl_f = rglru_direction(x_c, x_l, lam[0], wa[0], ba[0], wx[0], bx[0], ctx_out)
    hc_b, hl_b = rglru_direction(flip(x_c), flip(x_l), lam[1], wa[1], ba[1], wx[1], bx[1], ctx_out)
    y_l = (hl_f + flip(hl_b)).astype(x_l.dtype)
    y_c = (hc_f + flip(hc_b)).astype(x_c.dtype) if ctx_out else None
    return y_c, y_l


def odd_mixer(h, hc, w_in, w_out, lam_re, lam_im, log_dt, b_re, b_im, c_re, c_im, d_skip, glu_w, glu_b, conv_w, conv_b, lam, wa, ba, wx, bx, ctx_out):
    u_l, xd_l, gc_l, gd_l = jnp.split(h @ w_in, ODD_SPLITS, axis=-1)
    if ctx_out:
        u_c, xd_c, gc_c, gd_c = jnp.split(hc @ w_in, ODD_SPLITS, axis=-1)
    else:
        u_c, xd_c = jnp.split(hc @ w_in[:, :C_WIDTH + D_WIDTH], (C_WIDTH,), axis=-1)
    s5_c, s5_l = s5_mixer(u_c, u_l, lam_re, lam_im, log_dt, b_re, b_im, c_re, c_im, d_skip, glu_w, glu_b, ctx_out)
    lru_c, lru_l = rglru_mixer(xd_c, xd_l, conv_w, conv_b, lam, wa, ba, wx, bx, ctx_out)
    out_l = jnp.concatenate([s5_l * jax.nn.silu(gc_l), lru_l * jax.nn.silu(gd_l)], axis=-1) @ w_out
    if not ctx_out:
        return out_l, None
    out_c = jnp.concatenate([s5_c * jax.nn.silu(gc_c), lru_c * jax.nn.silu(gd_c)], axis=-1) @ w_out
    return out_l, out_c


def setup_inputs(seed: int = 0) -> dict:
    key = jax.random.key(seed)
    keys = jax.random.split(key, 40)
    ks = [keys[i] for i in range(40)]
    f32 = jnp.float32

    def nrm(shape, std):
        return jax.random.normal(ks.pop(), shape, f32) * std

    def near_one(shape):
        return 1.0 + nrm(shape, 0.02)

    d = D_MODEL
    x = nrm((BATCH, SEQ, d), 1.0)
    c = nrm((BATCH, d), 1.0)
    ctx = nrm((BATCH, CTX_LEN, d), 1.0)
    c_ctx = nrm((d,), 1.0)
    ada_w = nrm((DEPTH, d, 3 * d), 0.5 * d ** -0.5)
    ada_b = nrm((DEPTH, 3 * d), 0.02)
    norm_g = near_one((DEPTH, d))
    ev_w_in = nrm((N_EVEN, d, EVEN_IN), d ** -0.5)
    ev_w_out = nrm((N_EVEN, EVEN_MIX, d), EVEN_MIX ** -0.5)
    ev_q_g = near_one((N_EVEN, HEAD_DIM))
    ev_k_g = near_one((N_EVEN, HEAD_DIM))
    ev_sgu_g = near_one((N_EVEN, B_WIDTH))
    ev_ws = nrm((N_EVEN, B_GROUPS, CHUNK, CHUNK), CHUNK ** -0.5)
    ev_bs = near_one((N_EVEN, B_GROUPS, CHUNK))
    od_w_in = nrm((N_ODD, d, ODD_IN), d ** -0.5)
    od_w_out = nrm((N_ODD, ODD_MIX, d), ODD_MIX ** -0.5)
    sshape = (N_ODD, N_DIR, C_GROUPS, C_STATE)
    s5_lam_re = -0.5 + nrm(sshape, 0.01)
    s5_lam_im = math.pi * jnp.arange(C_STATE, dtype=f32) + nrm(sshape, 0.01)
    s5_log_dt = jax.random.uniform(ks.pop(), (N_ODD, N_DIR, C_GROUPS), f32, math.log(1e-3), math.log(1e-1))
    s5_b_re = nrm((N_ODD, N_DIR, C_GROUPS, C_STATE, C_GROUP_DIM), C_GROUP_DIM ** -0.5)
    s5_b_im = nrm((N_ODD, N_DIR, C_GROUPS, C_STATE, C_GROUP_DIM), C_GROUP_DIM ** -0.5)
    s5_c_re = nrm((N_ODD, N_DIR, C_GROUPS, C_GROUP_DIM, C_STATE), 0.5 ** 0.5)
    s5_c_im = nrm((N_ODD, N_DIR, C_GROUPS, C_GROUP_DIM, C_STATE), 0.5 ** 0.5)
    s5_d = nrm((N_ODD, C_WIDTH), 1.0)
    s5_glu_w = nrm((N_ODD, C_WIDTH, C_WIDTH), C_WIDTH ** -0.5)
    s5_glu_b = nrm((N_ODD, C_WIDTH), 0.02)
    lru_conv_w = nrm((N_ODD, CONV_W, D_WIDTH), CONV_W ** -0.5)
    lru_conv_b = nrm((N_ODD, D_WIDTH), 0.02)
    a0 = jax.random.uniform(ks.pop(), (N_ODD, N_DIR, D_WIDTH), f32, 0.9, 0.999)
    s = a0 ** (1.0 / LRU_C)
    lru_lam = jnp.log(s) - jnp.log1p(-s)
    lru_wa = nrm((N_ODD, N_DIR, D_BLOCKS, D_BLOCK_DIM, D_BLOCK_DIM), D_BLOCK_DIM ** -0.5)
    lru_ba = nrm((N_ODD, N_DIR, D_WIDTH), 0.02)
    lru_wx = nrm((N_ODD, N_DIR, D_BLOCKS, D_BLOCK_DIM, D_BLOCK_DIM), D_BLOCK_DIM ** -0.5)
    lru_bx = nrm((N_ODD, N_DIR, D_WIDTH), 0.02)
    return {'x': x, 'c': c, 'ctx': ctx, 'c_ctx': c_ctx, 'ada_w': ada_w, 'ada_b': ada_b, 'norm_g': norm_g,
            'ev_w_in': ev_w_in, 'ev_w_out': ev_w_out, 'ev_q_g': ev_q_g, 'ev_k_g': ev_k_g, 'ev_sgu_g': ev_sgu_g,
            'ev_ws': ev_ws, 'ev_bs': ev_bs, 'od_w_in': od_w_in, 'od_w_out': od_w_out,
            's5_lam_re': s5_lam_re, 's5_lam_im': s5_lam_im, 's5_log_dt': s5_log_dt, 's5_b_re': s5_b_re,
            's5_b_im': s5_b_im, 's5_c_re': s5_c_re, 's5_c_im': s5_c_im, 's5_d': s5_d, 's5_glu_w': s5_glu_w,
            's5_glu_b': s5_glu_b, 'lru_conv_w': lru_conv_w, 'lru_conv_b': lru_conv_b, 'lru_lam': lru_lam,
            'lru_wa': lru_wa, 'lru_ba': lru_ba, 'lru_wx': lru_wx, 'lru_bx': lru_bx}


def reference(x, c, ctx, c_ctx, ada_w, ada_b, norm_g, ev_w_in, ev_w_out, ev_q_g, ev_k_g, ev_sgu_g, ev_ws, ev_bs,
              od_w_in, od_w_out, s5_lam_re, s5_lam_im, s5_log_dt, s5_b_re, s5_b_im, s5_c_re, s5_c_im, s5_d,
              s5_glu_w, s5_glu_b, lru_conv_w, lru_conv_b, lru_lam, lru_wa, lru_ba, lru_wx, lru_bx):
    rows = x.shape[1] // GRID_W
    cos, sin = axial_rope_tables(rows)
    for layer in range(DEPTH):
        ctx_out = layer < DEPTH - 1
        shift, scale, gate = adaln(c, ada_w[layer], ada_b[layer])
        shift_c, scale_c, gate_c = adaln(c_ctx, ada_w[layer], ada_b[layer])
        h = modulate(x, norm_g[layer], shift[:, None], scale[:, None])
        hc = modulate(ctx, norm_g[layer], shift_c, scale_c)
        j = layer // 2
        if layer % 2 == 0:
            out_l, out_c = even_mixer(h, hc, ev_w_in[j], ev_w_out[j], ev_q_g[j], ev_k_g[j], ev_sgu_g[j], ev_ws[j], ev_bs[j], cos, sin, ctx_out)
        else:
            out_l, out_c = odd_mixer(h, hc, od_w_in[j], od_w_out[j], s5_lam_re[j], s5_lam_im[j], s5_log_dt[j], s5_b_re[j], s5_b_im[j], s5_c_re[j], s5_c_im[j], s5_d[j], s5_glu_w[j], s5_glu_b[j], lru_conv_w[j], lru_conv_b[j], lru_lam[j], lru_wa[j], lru_ba[j], lru_wx[j], lru_bx[j], ctx_out)
        x = x + gate[:, None] * out_l
        if ctx_out:
            ctx = ctx + gate_c * out_c
    return x
```

```cpp
#include <hip/hip_runtime.h>
#include <hip/hip_cooperative_groups.h>
#include <cstdio>
namespace cg = cooperative_groups;

#ifndef MEGA
#define MEGA 0
#endif

typedef unsigned short u16;
typedef unsigned int u32;
using bf16x8 = __attribute__((ext_vector_type(8))) short;
using f32x4 = __attribute__((ext_vector_type(4))) float;
using u32x4 = __attribute__((ext_vector_type(4))) unsigned;
using u32x2 = __attribute__((ext_vector_type(2))) unsigned;
#define DI __device__ __forceinline__

constexpr int DM = 2048, SPB = 2304, ROWS = 9216;
constexpr int EV_IN = 5632, OD_IN = 4096;
constexpr float EPS = 1e-6f;
constexpr int EQ = 1024, EBU = 2560, EBV = 3072, EGA = 3584, EGB = 5120;
constexpr int OXD = 1024, OGC = 2048, OGD = 3072;
constexpr int SMEM_BYTES = 49152;
constexpr int NPHASE = 21;

constexpr size_t al(size_t x) { return (x + 255) & ~size_t(255); }
constexpr size_t OFF_MODS = 0;
constexpr size_t SZ_MODS = (size_t)4 * 5 * 6144 * 4;
constexpr size_t OFF_X = al(OFF_MODS + SZ_MODS);
constexpr size_t OFF_H = al(OFF_X + (size_t)ROWS * DM * 4);
constexpr size_t OFF_P = al(OFF_H + (size_t)ROWS * DM * 2);
constexpr size_t OFF_MIX = al(OFF_P + (size_t)ROWS * EV_IN * 2);
constexpr size_t OFF_KB = al(OFF_MIX + (size_t)ROWS * DM * 2);
constexpr size_t OFF_VT = al(OFF_KB + (size_t)16 * 2304 * 128 * 2);
constexpr size_t OFF_ROPE = al(OFF_VT + (size_t)16 * 2304 * 128 * 2);
constexpr size_t OFF_WEVIN = al(OFF_ROPE + (size_t)2 * 2048 * 64 * 4);
constexpr size_t OFF_WEVOUT = al(OFF_WEVIN + (size_t)2 * 5632 * 2048 * 2);
constexpr size_t OFF_WODIN = al(OFF_WEVOUT + (size_t)2 * 2048 * 2048 * 2);
constexpr size_t OFF_WODOUT = al(OFF_WODIN + (size_t)2 * 4096 * 2048 * 2);
constexpr size_t OFF_WGLU = al(OFF_WODOUT + (size_t)2 * 2048 * 2048 * 2);
constexpr size_t OFF_YG = al(OFF_WGLU + (size_t)2 * 1024 * 1024 * 2);
constexpr size_t OFF_E = al(OFF_YG + (size_t)ROWS * 1024 * 2);
constexpr size_t OFF_LA = al(OFF_E + (size_t)2 * 4 * 64 * 18 * 64 * 2 * 4);
constexpr size_t OFF_LB = al(OFF_LA + (size_t)2 * ROWS * 1024 * 4);
constexpr size_t OFF_SA = al(OFF_LB + (size_t)2 * ROWS * 1024 * 4);
constexpr size_t OFF_SB = al(OFF_SA + (size_t)2 * 4 * 144 * 1024 * 4);
constexpr size_t OFF_CIN = al(OFF_SB + (size_t)2 * 4 * 144 * 1024 * 4);
constexpr size_t WS_TOTAL = al(OFF_CIN + (size_t)2 * 4 * 144 * 1024 * 4);

struct Params {
  const float *x, *c, *ctx, *c_ctx, *ada_w, *ada_b, *norm_g, *ev_w_in, *ev_w_out, *ev_q_g, *ev_k_g, *ev_sgu_g, *ev_ws,
      *ev_bs, *od_w_in, *od_w_out, *s5_lam_re, *s5_lam_im, *s5_log_dt, *s5_b_re, *s5_b_im, *s5_c_re, *s5_c_im, *s5_d,
      *s5_glu_w, *s5_glu_b, *lru_conv_w, *lru_conv_b, *lru_lam, *lru_wa, *lru_ba, *lru_wx, *lru_bx;
  float* out;
  char* ws;
};

DI u16 f2bf(float x) {
  u32 u = __float_as_uint(x);
  u += 0x7fffu + ((u >> 16) & 1u);
  return (u16)(u >> 16);
}
DI float bf2f(u16 v) { return __uint_as_float(((u32)v) << 16); }
DI float blo(u32 v) { return __uint_as_float(v << 16); }
DI float bhi(u32 v) { return __uint_as_float(v & 0xffff0000u); }
DI u32 pk(float a, float b) { return (u32)f2bf(a) | ((u32)f2bf(b) << 16); }
DI float sigmoidf_(float x) { return 1.f / (1.f + __expf(-x)); }
DI float siluf_(float x) { return x / (1.f + __expf(-x)); }
DI float red16(float v) {
  v += __shfl_xor(v, 1);
  v += __shfl_xor(v, 2);
  v += __shfl_xor(v, 4);
  v += __shfl_xor(v, 8);
  return v;
}
DI float wave_sum(float v) {
  v = red16(v);
  v += __shfl_xor(v, 16);
  v += __shfl_xor(v, 32);
  return v;
}
DI float wave_max(float v) {
#pragma unroll
  for (int o = 1; o < 64; o <<= 1) v = fmaxf(v, __shfl_xor(v, o));
  return v;
}
DI void unpack8(u32x4 q, float* v) {
#pragma unroll
  for (int e = 0; e < 4; ++e) {
    v[2 * e] = blo(q[e]);
    v[2 * e + 1] = bhi(q[e]);
  }
}
DI u32x4 pack8(const float* v) {
  u32x4 q;
#pragma unroll
  for (int e = 0; e < 4; ++e) q[e] = pk(v[2 * e], v[2 * e + 1]);
  return q;
}

DI float* ws_mods(const Params& p) { return (float*)(p.ws + OFF_MODS); }
DI float* ws_X(const Params& p) { return (float*)(p.ws + OFF_X); }
DI u16* ws_H(const Params& p) { return (u16*)(p.ws + OFF_H); }
DI u16* ws_P(const Params& p) { return (u16*)(p.ws + OFF_P); }
DI u16* ws_MIX(const Params& p) { return (u16*)(p.ws + OFF_MIX); }
DI u16* ws_KB(const Params& p) { return (u16*)(p.ws + OFF_KB); }
DI u16* ws_VT(const Params& p) { return (u16*)(p.ws + OFF_VT); }
DI float* ws_ROPE(const Params& p) { return (float*)(p.ws + OFF_ROPE); }
DI u16* ws_YG(const Params& p) { return (u16*)(p.ws + OFF_YG); }
DI float* ws_E(const Params& p) { return (float*)(p.ws + OFF_E); }
DI float* ws_LA(const Params& p) { return (float*)(p.ws + OFF_LA); }
DI float* ws_LB(const Params& p) { return (float*)(p.ws + OFF_LB); }
DI float* ws_SA(const Params& p) { return (float*)(p.ws + OFF_SA); }
DI float* ws_SB(const Params& p) { return (float*)(p.ws + OFF_SB); }
DI float* ws_CIN(const Params& p) { return (float*)(p.ws + OFF_CIN); }

__device__ void phase_prep(const Params& p, int bid, int nb, char* smem) {
  const int tid = threadIdx.x;
  constexpr int N_ADA = 4 * 24 * 16;
  constexpr int T_EVIN = 2 * 32 * 88, T_EVOUT = 2 * 32 * 32, T_ODIN = 2 * 32 * 64, T_ODOUT = 2 * 32 * 32,
                T_GLU = 2 * 16 * 16;
  constexpr int N_TR = T_EVIN + T_EVOUT + T_ODIN + T_ODOUT + T_GLU;
  constexpr int N_ROPE = 512;
  float* sf = (float*)smem;
  for (int item = bid; item < N_ADA + N_TR + N_ROPE; item += nb) {
    if (item < N_ADA) {
      const int l = item / 384, rem = item % 384, cb = rem / 16, kc = rem % 16;
      const int n = cb * 256 + tid;
      if (tid < 128) {
#pragma unroll
        for (int i = 0; i < 5; ++i) {
          float cv = (i < 4) ? p.c[i * 2048 + kc * 128 + tid] : p.c_ctx[kc * 128 + tid];
          sf[i * 128 + tid] = cv / (1.f + expf(-cv));
        }
      }
      __syncthreads();
      float acc[5] = {0.f, 0.f, 0.f, 0.f, 0.f};
      const float* w = p.ada_w + ((size_t)l * 2048 + kc * 128) * 6144 + n;
#pragma unroll 8
      for (int k = 0; k < 128; ++k) {
        float wv = w[(size_t)k * 6144];
#pragma unroll
        for (int i = 0; i < 5; ++i) acc[i] += sf[i * 128 + k] * wv;
      }
      float bias = (kc == 0) ? p.ada_b[l * 6144 + n] : 0.f;
      float* mods = ws_mods(p);
#pragma unroll
      for (int i = 0; i < 5; ++i) atomicAdd(&mods[(size_t)(l * 5 + i) * 6144 + n], acc[i] + bias);
      __syncthreads();
    } else if (item < N_ADA + N_TR) {
      int t = item - N_ADA;
      const float* src;
      u16* dst;
      int K, N;
      if (t < T_EVIN) {
        K = 2048; N = 5632; src = p.ev_w_in; dst = (u16*)(p.ws + OFF_WEVIN);
      } else if ((t -= T_EVIN) < T_EVOUT) {
        K = 2048; N = 2048; src = p.ev_w_out; dst = (u16*)(p.ws + OFF_WEVOUT);
      } else if ((t -= T_EVOUT) < T_ODIN) {
        K = 2048; N = 4096; src = p.od_w_in; dst = (u16*)(p.ws + OFF_WODIN);
      } else if ((t -= T_ODIN) < T_ODOUT) {
        K = 2048; N = 2048; src = p.od_w_out; dst = (u16*)(p.ws + OFF_WODOUT);
      } else {
        t -= T_ODOUT;
        K = 1024; N = 1024; src = p.s5_glu_w; dst = (u16*)(p.ws + OFF_WGLU);
      }
      const int ntn = N / 64, tpm = (K / 64) * ntn;
      const int mat = t / tpm, tt = t % tpm, kt = tt / ntn, nt = tt % ntn;
      src += (size_t)mat * K * N;
      dst += (size_t)mat * K * N;
#pragma unroll
      for (int i = 0; i < 16; ++i) {
        int k = i * 4 + (tid >> 6), n = tid & 63;
        sf[k * 65 + n] = src[(size_t)(kt * 64 + k) * N + nt * 64 + n];
      }
      __syncthreads();
      {
        const int n = tid >> 2, ks = (tid & 3) * 16;
        float v[16];
#pragma unroll
        for (int j = 0; j < 16; ++j) v[j] = sf[(ks + j) * 65 + n];
        u32x4* d = (u32x4*)(dst + (size_t)(nt * 64 + n) * K + kt * 64 + ks);
        d[0] = pack8(v);
        d[1] = pack8(v + 8);
      }
      __syncthreads();
    } else {
      const int idx = (item - N_ADA - N_TR) * 256 + tid;
      const int i = idx & 63, tok = idx >> 6;
      const int row = tok >> 6, col = tok & 63, m = i & 31;
      const float pos = (float)((i < 32) ? row : col);
      const float inv = powf(10000.f, -(float)(2 * m) / 64.f);
      const float ang = pos * inv;
      float* rp = ws_ROPE(p);
      rp[idx] = cosf(ang);
      rp[2048 * 64 + idx] = sinf(ang);
    }
  }
}

__device__ void phase_norm(const Params& p, int layer, int bid, int nb) {
  const int lane = threadIdx.x & 63, wave = threadIdx.x >> 6;
  float* X = ws_X(p);
  u16* H = ws_H(p);
  const float* g = p.norm_g + layer * 2048;
  for (int item = bid; item < ROWS / 4; item += nb) {
    const int r = item * 4 + wave;
    const int b = r / SPB, s = r % SPB;
    const float* src;
    if (layer == 0)
      src = (s < 256) ? p.ctx + ((size_t)b * 256 + s) * 2048 : p.x + ((size_t)b * 2048 + (s - 256)) * 2048;
    else
      src = X + (size_t)r * 2048;
    const int mi = (s < 256) ? 4 : b;
    const float* md = ws_mods(p) + (size_t)(layer * 5 + mi) * 6144;
    f32x4 v[8];
    float ss = 0.f;
#pragma unroll
    for (int i = 0; i < 8; ++i) {
      v[i] = *(const f32x4*)(src + (i * 64 + lane) * 4);
      ss += v[i][0] * v[i][0] + v[i][1] * v[i][1] + v[i][2] * v[i][2] + v[i][3] * v[i][3];
    }
    ss = wave_sum(ss);
    const float rstd = rsqrtf(ss * (1.f / 2048.f) + EPS);
#pragma unroll
    for (int i = 0; i < 8; ++i) {
      const int c = (i * 64 + lane) * 4;
      f32x4 gv = *(const f32x4*)(g + c);
      f32x4 sh = *(const f32x4*)(md + c);
      f32x4 sc = *(const f32x4*)(md + 2048 + c);
      float h0 = v[i][0] * rstd * gv[0] * (1.f + sc[0]) + sh[0];
      float h1 = v[i][1] * rstd * gv[1] * (1.f + sc[1]) + sh[1];
      float h2 = v[i][2] * rstd * gv[2] * (1.f + sc[2]) + sh[2];
      float h3 = v[i][3] * rstd * gv[3] * (1.f + sc[3]) + sh[3];
      u32x2 o;
      o[0] = pk(h0, h1);
      o[1] = pk(h2, h3);
      *(u32x2*)(H + (size_t)r * 2048 + c) = o;
      if (layer == 0) *(f32x4*)(X + (size_t)r * 2048 + c) = v[i];
    }
  }
}

constexpr int LST = 72;

template <class Epi>
DI void gemm_tile(const u16* __restrict__ A, int lda, const u16* __restrict__ Bt, int ldb, int K, int m0, int n0,
                  char* smem, Epi& epi) {
  u16* sA = (u16*)smem;
  u16* sB = sA + 128 * LST;
  const int tid = threadIdx.x, lane = tid & 63, wave = tid >> 6, wm = wave >> 1, wn = wave & 1;
  const int fr = lane & 15, fq = lane >> 4;
  f32x4 acc[4][4];
#pragma unroll
  for (int i = 0; i < 4; ++i)
#pragma unroll
    for (int j = 0; j < 4; ++j) acc[i][j] = f32x4{0.f, 0.f, 0.f, 0.f};
  const int lrow = tid >> 3, lkc = (tid & 7) * 8;
  const u16* Ag = A + (size_t)(m0 + lrow) * lda + lkc;
  const u16* Bg = Bt + (size_t)(n0 + lrow) * ldb + lkc;
  u32x4 ra[4], rb[4];
#pragma unroll
  for (int i = 0; i < 4; ++i) {
    ra[i] = *(const u32x4*)(Ag + (size_t)(i * 32) * lda);
    rb[i] = *(const u32x4*)(Bg + (size_t)(i * 32) * ldb);
  }
  for (int k0 = 0; k0 < K; k0 += 64) {
    __syncthreads();
#pragma unroll
    for (int i = 0; i < 4; ++i) {
      *(u32x4*)(sA + (lrow + i * 32) * LST + lkc) = ra[i];
      *(u32x4*)(sB + (lrow + i * 32) * LST + lkc) = rb[i];
    }
    __syncthreads();
    if (k0 + 64 < K) {
#pragma unroll
      for (int i = 0; i < 4; ++i) {
        ra[i] = *(const u32x4*)(Ag + (size_t)(i * 32) * lda + k0 + 64);
        rb[i] = *(const u32x4*)(Bg + (size_t)(i * 32) * ldb + k0 + 64);
      }
    }
#pragma unroll
    for (int ks = 0; ks < 2; ++ks) {
      bf16x8 af[4], bfr[4];
#pragma unroll
      for (int i = 0; i < 4; ++i) af[i] = *(const bf16x8*)(sA + (wm * 64 + i * 16 + fr) * LST + ks * 32 + fq * 8);
#pragma unroll
      for (int j = 0; j < 4; ++j) bfr[j] = *(const bf16x8*)(sB + (wn * 64 + j * 16 + fr) * LST + ks * 32 + fq * 8);
#pragma unroll
      for (int i = 0; i < 4; ++i)
#pragma unroll
        for (int j = 0; j < 4; ++j) acc[i][j] = __builtin_amdgcn_mfma_f32_16x16x32_bf16(af[i], bfr[j], acc[i][j], 0, 0, 0);
    }
  }
  float* T = (float*)smem;
  const bool tr = epi.transposed(n0);
#pragma unroll
  for (int half = 0; half < 2; ++half) {
    __syncthreads();
    if (wm == half) {
      if (!tr) {
#pragma unroll
        for (int i = 0; i < 4; ++i)
#pragma unroll
          for (int j = 0; j < 4; ++j)
#pragma unroll
            for (int e = 0; e < 4; ++e) T[(i * 16 + fq * 4 + e) * 132 + wn * 64 + j * 16 + fr] = acc[i][j][e];
      } else {
#pragma unroll
        for (int i = 0; i < 4; ++i)
#pragma unroll
          for (int j = 0; j < 4; ++j) *(f32x4*)(T + (wn * 64 + j * 16 + fr) * 68 + i * 16 + fq * 4) = acc[i][j];
      }
    }
    __syncthreads();
    if (!tr) {
#pragma unroll
      for (int pass = 0; pass < 4; ++pass) {
        const int lr = pass * 16 + (tid >> 4), c0 = (tid & 15) * 8;
        float v[8];
        f32x4 t0 = *(const f32x4*)(T + lr * 132 + c0), t1 = *(const f32x4*)(T + lr * 132 + c0 + 4);
        v[0] = t0[0]; v[1] = t0[1]; v[2] = t0[2]; v[3] = t0[3];
        v[4] = t1[0]; v[5] = t1[1]; v[6] = t1[2]; v[7] = t1[3];
        epi.row(m0 + half * 64 + lr, n0 + c0, v);
      }
    } else {
#pragma unroll
      for (int pass = 0; pass < 4; ++pass) {
        const int lc = pass * 32 + (tid >> 3), r0 = (tid & 7) * 8;
        float v[8];
        f32x4 t0 = *(const f32x4*)(T + lc * 68 + r0), t1 = *(const f32x4*)(T + lc * 68 + r0 + 4);
        v[0] = t0[0]; v[1] = t0[1]; v[2] = t0[2]; v[3] = t0[3];
        v[4] = t1[0]; v[5] = t1[1]; v[6] = t1[2]; v[7] = t1[3];
        epi.col(n0 + lc, m0 + half * 64 + r0, v);
      }
    }
  }
}

struct EpiEvenIn {
  const Params& p;
  int j;
  DI bool transposed(int n0) const { return (n0 >> 7) >= 4 && (n0 >> 7) < 8; }
  DI void row(int r, int c, float* v) const {
    const int nt = c >> 7, cc = c & 127;
    const int b = r / SPB, s = r % SPB;
    u16* dst = ws_P(p) + (size_t)r * EV_IN + c;
    if (nt < 4 || (nt >= 8 && nt < 20)) {
      float ss = 0.f;
#pragma unroll
      for (int e = 0; e < 8; ++e) ss += v[e] * v[e];
      ss = red16(ss);
      const float rstd = rsqrtf(ss * (1.f / 128.f) + EPS);
      const float* g = ((nt < 4) ? p.ev_k_g : p.ev_q_g) + j * 128 + cc;
#pragma unroll
      for (int e = 0; e < 8; ++e) v[e] = v[e] * rstd * g[e];
      if (s >= 256) {
        const int tok = s - 256;
        const float* rc = ws_ROPE(p) + tok * 64 + (cc >> 1);
        const float* rs = rc + 2048 * 64;
#pragma unroll
        for (int e = 0; e < 4; ++e) {
          const float cs = rc[e], sn = rs[e];
          const float x0 = v[2 * e], x1 = v[2 * e + 1];
          v[2 * e] = x0 * cs - x1 * sn;
          v[2 * e + 1] = x0 * sn + x1 * cs;
        }
      }
      if (nt < 4) dst = ws_KB(p) + ((size_t)(b * 4 + nt) * 2304 + s) * 128 + cc;
    } else if (nt >= 24 && nt < 28) {
      float ss = 0.f;
#pragma unroll
      for (int e = 0; e < 8; ++e) ss += v[e] * v[e];
      ss = red16(ss);
      const float rstd = rsqrtf(ss * (1.f / 128.f) + EPS);
      const float* g = p.ev_sgu_g + j * 512 + (nt - 24) * 128 + cc;
#pragma unroll
      for (int e = 0; e < 8; ++e) v[e] = v[e] * rstd * g[e];
    } else if (nt >= 28) {
#pragma unroll
      for (int e = 0; e < 8; ++e) v[e] = siluf_(v[e]);
    }
    *(u32x4*)dst = pack8(v);
  }
  DI void col(int c, int r0, float* v) const {
    const int kvh = (c >> 7) - 4, d = c & 127;
    const int b = r0 / SPB, s = r0 % SPB;
    *(u32x4*)(ws_VT(p) + ((size_t)(b * 4 + kvh) * 128 + d) * 2304 + s) = pack8(v);
  }
};

struct EpiOddIn {
  const Params& p;
  DI bool transposed(int) const { return false; }
  DI void row(int r, int c, float* v) const {
    if (c >= OGC) {
#pragma unroll
      for (int e = 0; e < 8; ++e) v[e] = siluf_(v[e]);
    }
    *(u32x4*)(ws_P(p) + (size_t)r * OD_IN + c) = pack8(v);
  }
  DI void col(int, int, float*) const {}
};

struct EpiOut {
  const Params& p;
  int layer;
  DI bool transposed(int) const { return false; }
  DI void row(int r, int c, float* v) const {
    const int b = r / SPB, s = r % SPB;
    const int mi = (s < 256) ? 4 : b;
    const float* gate = ws_mods(p) + (size_t)(layer * 5 + mi) * 6144 + 4096 + c;
    float* xp = ws_X(p) + (size_t)r * 2048 + c;
    f32x4 x0 = *(const f32x4*)xp, x1 = *(const f32x4*)(xp + 4);
    f32x4 g0 = *(const f32x4*)gate, g1 = *(const f32x4*)(gate + 4);
#pragma unroll
    for (int e = 0; e < 4; ++e) {
      x0[e] += g0[e] * v[e];
      x1[e] += g1[e] * v[4 + e];
    }
    if (layer == 3) {
      if (s >= 256) {
        float* o = p.out + ((size_t)b * 2048 + (s - 256)) * 2048 + c;
        *(f32x4*)o = x0;
        *(f32x4*)(o + 4) = x1;
      }
    } else {
      *(f32x4*)xp = x0;
      *(f32x4*)(xp + 4) = x1;
    }
  }
  DI void col(int, int, float*) const {}
};

struct EpiGlu {
  const Params& p;
  int j;
  DI bool transposed(int) const { return false; }
  DI void row(int r, int c, float* v) const {
    float yg[8], gc[8];
    unpack8(*(const u32x4*)(ws_YG(p) + (size_t)r * 1024 + c), yg);
    unpack8(*(const u32x4*)(ws_P(p) + (size_t)r * OD_IN + OGC + c), gc);
    const float* gb = p.s5_glu_b + j * 1024 + c;
#pragma unroll
    for (int e = 0; e < 8; ++e) v[e] = yg[e] * sigmoidf_(v[e] + gb[e]) * gc[e];
    *(u32x4*)(ws_MIX(p) + (size_t)r * 2048 + c) = pack8(v);
  }
  DI void col(int, int, float*) const {}
};

__device__ void phase_gemm_in(const Params& p, int layer, int bid, int nb, char* smem) {
  const int j = layer >> 1;
  if ((layer & 1) == 0) {
    EpiEvenIn epi{p, j};
    const u16* W = (const u16*)(p.ws + OFF_WEVIN) + (size_t)j * EV_IN * 2048;
    constexpr int NT = EV_IN / 128;
    for (int item = bid; item < 72 * NT; item += nb) {
      const int mt = item / NT, nt = item % NT;
      gemm_tile(ws_H(p), 2048, W, 2048, 2048, mt * 128, nt * 128, smem, epi);
    }
  } else {
    EpiOddIn epi{p};
    const u16* W = (const u16*)(p.ws + OFF_WODIN) + (size_t)j * OD_IN * 2048;
    constexpr int NT = OD_IN / 128;
    for (int item = bid; item < 72 * NT; item += nb) {
      const int mt = item / NT, nt = item % NT;
      gemm_tile(ws_H(p), 2048, W, 2048, 2048, mt * 128, nt * 128, smem, epi);
    }
  }
}

__device__ void phase_gemm_out(const Params& p, int layer, int bid, int nb, char* smem) {
  const int j = layer >> 1;
  EpiOut epi{p, layer};
  const u16* W = (const u16*)(p.ws + ((layer & 1) ? OFF_WODOUT : OFF_WEVOUT)) + (size_t)j * 2048 * 2048;
  for (int item = bid; item < 72 * 16; item += nb) {
    const int mt = item / 16, nt = item % 16;
    gemm_tile(ws_MIX(p), 2048, W, 2048, 2048, mt * 128, nt * 128, smem, epi);
  }
}

__device__ void phase_even_mix(const Params& p, int layer, int bid, int nb, char* smem) {
  const int j = layer >> 1;
  const int tid = threadIdx.x, lane = tid & 63, wave = tid >> 6;
  const u16* P = ws_P(p);
  u16* MIX = ws_MIX(p);
  constexpr int N_ATT = 12 * 2304;
  constexpr int N_SGU = ROWS * 2;
  for (int item = bid; item < N_ATT + N_SGU; item += nb) {
    if (item < N_ATT) {
      const int h = item / 2304, rq = item % 2304;
      const int r = rq * 4 + wave;
      const int b = r / SPB, s = r % SPB;
      const int nk = (s < 256) ? 256 : 2304;
      const int kvh = h / 3;
      float* sc = (float*)smem + wave * 2304;
      u16* qs = (u16*)(smem + 36864) + wave * 128;
      *(u32*)(qs + lane * 2) = *(const u32*)(P + (size_t)r * EV_IN + EQ + h * 128 + lane * 2);
      __syncthreads();
      const u16* Kp = ws_KB(p) + (size_t)(b * 4 + kvh) * 2304 * 128;
      float mx = -1e30f;
      for (int key = lane; key < nk; key += 64) {
        const u32x4* kr = (const u32x4*)(Kp + (size_t)key * 128);
        float dot = 0.f;
#pragma unroll
        for (int ch = 0; ch < 16; ++ch) {
          u32x4 kv = kr[ch];
          u32x4 qv = *(const u32x4*)(qs + ch * 8);
#pragma unroll
          for (int e = 0; e < 4; ++e) dot += blo(kv[e]) * blo(qv[e]) + bhi(kv[e]) * bhi(qv[e]);
        }
        dot *= 0.08838834764831845f;
        sc[key] = dot;
        mx = fmaxf(mx, dot);
      }
      mx = wave_max(mx);
      float sum = 0.f;
      for (int key = lane; key < nk; key += 64) {
        float e = __expf(sc[key] - mx);
        sc[key] = e;
        sum += e;
      }
      sum = wave_sum(sum);
      __syncthreads();
      const u16* V0 = ws_VT(p) + ((size_t)(b * 4 + kvh) * 128 + lane * 2) * 2304;
      const u16* V1 = V0 + 2304;
      float o0 = 0.f, o1 = 0.f;
      for (int k8 = 0; k8 < nk; k8 += 8) {
        u32x4 v0 = *(const u32x4*)(V0 + k8), v1 = *(const u32x4*)(V1 + k8);
        f32x4 p0 = *(const f32x4*)(sc + k8), p1 = *(const f32x4*)(sc + k8 + 4);
        o0 += blo(v0[0]) * p0[0] + bhi(v0[0]) * p0[1] + blo(v0[1]) * p0[2] + bhi(v0[1]) * p0[3] + blo(v0[2]) * p1[0] +
              bhi(v0[2]) * p1[1] + blo(v0[3]) * p1[2] + bhi(v0[3]) * p1[3];
        o1 += blo(v1[0]) * p0[0] + bhi(v1[0]) * p0[1] + blo(v1[1]) * p0[2] + bhi(v1[1]) * p0[3] + blo(v1[2]) * p1[0] +
              bhi(v1[2]) * p1[1] + blo(v1[3]) * p1[2] + bhi(v1[3]) * p1[3];
      }
      const float inv = 1.f / sum;
      const u32 ga = *(const u32*)(P + (size_t)r * EV_IN + EGA + h * 128 + lane * 2);
      *(u32*)(MIX + (size_t)r * 2048 + h * 128 + lane * 2) = pk(o0 * inv * blo(ga), o1 * inv * bhi(ga));
      __syncthreads();
    } else {
      const int it = item - N_ATT;
      const int r = it >> 1, jc = (it & 1) * 256 + tid;
      const int g = jc >> 7;
      const int rb = (r >> 7) << 7, pp = r & 127;
      const float* Ws = p.ev_ws + ((size_t)(j * 4 + g) * 128 + pp) * 128;
      const u16* vn = P + (size_t)rb * EV_IN + EBV + jc;
      float acc = 0.f;
#pragma unroll 8
      for (int q = 0; q < 128; ++q) acc += Ws[q] * bf2f(vn[(size_t)q * EV_IN]);
      const float mixed = acc + p.ev_bs[(j * 4 + g) * 128 + pp];
      const float u = bf2f(P[(size_t)r * EV_IN + EBU + jc]);
      const float gb = bf2f(P[(size_t)r * EV_IN + EGB + jc]);
      MIX[(size_t)r * 2048 + 1536 + jc] = f2bf(u * mixed * gb);
    }
  }
}

struct S5P {
  float ar, ai;
  float bre[16], bim[16];
};
DI void s5_setup(const Params& p, int jl, int dir, int g, int n, S5P& q) {
  const size_t gi = (size_t)(jl * 2 + dir) * 64 + g;
  const float lre = p.s5_lam_re[gi * 64 + n], lim = p.s5_lam_im[gi * 64 + n];
  const float dt = expf(p.s5_log_dt[gi]);
  const float mag = expf(lre * dt);
  const float ang = lim * dt;
  q.ar = mag * cosf(ang);
  q.ai = mag * sinf(ang);
  const float xr = q.ar - 1.f, xi = q.ai;
  const float den = lre * lre + lim * lim;
  const float cr = (xr * lre + xi * lim) / den, ci = (xi * lre - xr * lim) / den;
  const float* br = p.s5_b_re + (gi * 64 + n) * 16;
  const float* bi = p.s5_b_im + (gi * 64 + n) * 16;
#pragma unroll
  for (int k = 0; k < 16; ++k) {
    const float a = br[k], b = bi[k];
    q.bre[k] = cr * a - ci * b;
    q.bim[k] = cr * b + ci * a;
  }
}
DI void s5_drive(const S5P& q, const u16* us, int t, float& hr, float& hi, float* u) {
  const u32x4* up = (const u32x4*)(us + t * 16);
  unpack8(up[0], u);
  unpack8(up[1], u + 8);
  float dr = 0.f, di = 0.f;
#pragma unroll
  for (int k = 0; k < 16; ++k) {
    dr += q.bre[k] * u[k];
    di += q.bim[k] * u[k];
  }
  const float nr = q.ar * hr - q.ai * hi + dr;
  const float ni = q.ar * hi + q.ai * hr + di;
  hr = nr;
  hi = ni;
}
DI void s5_load_u(const Params& p, int b, int seg, int g, u16* us, int lane) {
  const u16* P = ws_P(p);
#pragma unroll
  for (int i = 0; i < 4; ++i) {
    const int id = lane + 64 * i, t = id >> 1, hf = id & 1;
    *(u32x4*)(us + t * 16 + hf * 8) = *(const u32x4*)(P + (size_t)(b * SPB + seg * 128 + t) * OD_IN + g * 16 + hf * 8);
  }
}

__device__ void phase_odd3(const Params& p, int layer, int bid, int nb, char* smem) {
  const int jl = layer >> 1;
  const int tid = threadIdx.x, lane = tid & 63, wave = tid >> 6;
  const u16* P = ws_P(p);
  constexpr int N_LRU = 576 * 8;
  constexpr int N_S5A = 2304;
  for (int item = bid; item < N_LRU + N_S5A; item += nb) {
    if (item < N_S5A) {
      const int w = item * 4 + wave;
      const int seg = w % 18, dir = (w / 18) & 1, g = (w / 36) & 63, b = w / (36 * 64);
      u16* us = (u16*)smem + wave * 2048;
      s5_load_u(p, b, seg, g, us, lane);
      S5P q;
      s5_setup(p, jl, dir, g, lane, q);
      __syncthreads();
      float hr = 0.f, hi = 0.f, u[16];
      for (int tt = 0; tt < 128; ++tt) {
        const int t = dir ? 127 - tt : tt;
        s5_drive(q, us, t, hr, hi, u);
      }
      float* E = ws_E(p) + ((((size_t)dir * 4 + b) * 64 + g) * 18 + seg) * 128;
      E[lane * 2] = hr;
      E[lane * 2 + 1] = hi;
      __syncthreads();
    } else {
      const int it = item - N_S5A;
      const int c16 = it >> 3, h = it & 7;
      const int r0 = c16 * 16, b = r0 / SPB, s0 = r0 % SPB;
      const int lo = (s0 < 256) ? 0 : 256, hi_ = (s0 < 256) ? 256 : 2304;
      float* xcT = (float*)smem;
#pragma unroll
      for (int k = 0; k < 8; ++k) {
        const int idx = tid + 256 * k, rr = idx >> 7, ch = idx & 127;
        const int chg = h * 128 + ch;
        float a = p.lru_conv_b[jl * 1024 + chg];
#pragma unroll
        for (int kk = 0; kk < 4; ++kk) {
          const int s = s0 + rr + kk - 1;
          if (s >= lo && s < hi_)
            a += p.lru_conv_w[(jl * 4 + kk) * 1024 + chg] * bf2f(P[(size_t)(b * SPB + s) * OD_IN + OXD + chg]);
        }
        xcT[ch * 16 + rr] = a;
      }
      __syncthreads();
      const int dir = tid >> 7, jj = tid & 127;
      float ar[16], ai[16];
#pragma unroll
      for (int k = 0; k < 16; ++k) {
        ar[k] = 0.f;
        ai[k] = 0.f;
      }
      const float* wa = p.lru_wa + ((size_t)((jl * 2 + dir) * 8 + h) * 128) * 128 + jj;
      const float* wx = p.lru_wx + ((size_t)((jl * 2 + dir) * 8 + h) * 128) * 128 + jj;
#pragma unroll 2
      for (int i = 0; i < 128; ++i) {
        const float wav = wa[i * 128], wxv = wx[i * 128];
        const f32x4* xp = (const f32x4*)(xcT + i * 16);
#pragma unroll
        for (int k4 = 0; k4 < 4; ++k4) {
          f32x4 xv = xp[k4];
#pragma unroll
          for (int e = 0; e < 4; ++e) {
            ar[k4 * 4 + e] += xv[e] * wav;
            ai[k4 * 4 + e] += xv[e] * wxv;
          }
        }
      }
      const int chg = h * 128 + jj;
      const int pi = (jl * 2 + dir) * 1024 + chg;
      const float ba = p.lru_ba[pi], bx = p.lru_bx[pi];
      const float lam = p.lru_lam[pi];
      const float c8 = -8.f * log1pf(expf(-lam));
      float av[16], bv[16];
#pragma unroll
      for (int k = 0; k < 16; ++k) {
        const float rg = 1.f / (1.f + expf(-(ar[k] + ba)));
        const float ig = 1.f / (1.f + expf(-(ai[k] + bx)));
        const float la = c8 * rg;
        av[k] = expf(la);
        bv[k] = sqrtf(-expm1f(2.f * la)) * (ig * xcT[jj * 16 + k]);
      }
      float* LA = ws_LA(p) + ((size_t)dir * ROWS + r0) * 1024 + chg;
      float* LB = ws_LB(p) + ((size_t)dir * ROWS + r0) * 1024 + chg;
#pragma unroll
      for (int k = 0; k < 16; ++k) {
        LA[(size_t)k * 1024] = av[k];
        LB[(size_t)k * 1024] = bv[k];
      }
      float Ap = 1.f, Bp = 0.f;
#pragma unroll
      for (int k = 0; k < 16; ++k) {
        const int kk = dir ? 15 - k : k;
        Bp = av[kk] * Bp + bv[kk];
        Ap *= av[kk];
      }
      const size_t si = (((size_t)dir * 4 + b) * 144 + (s0 >> 4)) * 1024 + chg;
      ws_SA(p)[si] = Ap;
      ws_SB(p)[si] = Bp;
      __syncthreads();
    }
  }
}

DI int s5_order_seg(int dir, int pos) { return dir ? (pos < 2 ? 1 - pos : 19 - pos) : pos; }
DI int s5_order_pos(int dir, int seg) { return dir ? (seg < 2 ? 1 - seg : 19 - seg) : seg; }

__device__ void phase_odd4(const Params& p, int layer, int bid, int nb, char* smem) {
  const int jl = layer >> 1;
  const int tid = threadIdx.x, lane = tid & 63, wave = tid >> 6;
  constexpr int N_CAR = 32;
  constexpr int N_S5B = 1152;
  for (int item = bid; item < N_CAR + N_S5B; item += nb) {
    if (item < N_CAR) {
      const int id = item * 256 + tid;
      const int ch = id & 1023, b = (id >> 10) & 3, dir = id >> 12;
      const float* SA = ws_SA(p) + ((size_t)dir * 4 + b) * 144 * 1024 + ch;
      const float* SBp = ws_SB(p) + ((size_t)dir * 4 + b) * 144 * 1024 + ch;
      float* CI = ws_CIN(p) + ((size_t)dir * 4 + b) * 144 * 1024 + ch;
      float h = 0.f;
#pragma unroll 8
      for (int k = 0; k < 144; ++k) {
        const int c = dir ? (k < 16 ? 15 - k : 159 - k) : k;
        CI[(size_t)c * 1024] = h;
        h = SA[(size_t)c * 1024] * h + SBp[(size_t)c * 1024];
      }
    } else {
      const int w = (item - N_CAR) * 4 + wave;
      const int seg = w % 18, g = (w / 18) & 63, b = w / (18 * 64);
      u16* us = (u16*)smem + wave * 2048;
      float* ys = (float*)(smem + 16384) + wave * 2048;
      s5_load_u(p, b, seg, g, us, lane);
      __syncthreads();
#pragma unroll 1
      for (int dir = 0; dir < 2; ++dir) {
        S5P q;
        s5_setup(p, jl, dir, g, lane, q);
        float pr = q.ar, pi_ = q.ai;
#pragma unroll
        for (int k = 0; k < 7; ++k) {
          const float nr = pr * pr - pi_ * pi_, ni = 2.f * pr * pi_;
          pr = nr;
          pi_ = ni;
        }
        float hr = 0.f, hi = 0.f;
        const int mypos = s5_order_pos(dir, seg);
        const float* E = ws_E(p) + (((size_t)dir * 4 + b) * 64 + g) * 18 * 128;
        for (int pos = 0; pos < mypos; ++pos) {
          const int sg = s5_order_seg(dir, pos);
          const float er = E[sg * 128 + lane * 2], ei = E[sg * 128 + lane * 2 + 1];
          const float nr = pr * hr - pi_ * hi + er, ni = pr * hi + pi_ * hr + ei;
          hr = nr;
          hi = ni;
        }
        float cre[16], cim[16];
        const size_t gi = (size_t)(jl * 2 + dir) * 64 + g;
#pragma unroll
        for (int k = 0; k < 16; ++k) {
          cre[k] = p.s5_c_re[(gi * 16 + k) * 64 + lane];
          cim[k] = p.s5_c_im[(gi * 16 + k) * 64 + lane];
        }
        const bool b5 = lane & 32, b4 = lane & 16, b3 = lane & 8, b2 = lane & 4;
        for (int tt = 0; tt < 128; ++tt) {
          const int t = dir ? 127 - tt : tt;
          float u[16];
          s5_drive(q, us, t, hr, hi, u);
          float wv[16];
#pragma unroll
          for (int k = 0; k < 16; ++k) wv[k] = cre[k] * hr - cim[k] * hi;
          float k8[8], k4[4], k2[2], k1;
#pragma unroll
          for (int i = 0; i < 8; ++i) {
            const float keep = b5 ? wv[8 + i] : wv[i], send = b5 ? wv[i] : wv[8 + i];
            k8[i] = keep + __shfl_xor(send, 32);
          }
#pragma unroll
          for (int i = 0; i < 4; ++i) {
            const float keep = b4 ? k8[4 + i] : k8[i], send = b4 ? k8[i] : k8[4 + i];
            k4[i] = keep + __shfl_xor(send, 16);
          }
#pragma unroll
          for (int i = 0; i < 2; ++i) {
            const float keep = b3 ? k4[2 + i] : k4[i], send = b3 ? k4[i] : k4[2 + i];
            k2[i] = keep + __shfl_xor(send, 8);
          }
          {
            const float keep = b2 ? k2[1] : k2[0], send = b2 ? k2[0] : k2[1];
            k1 = keep + __shfl_xor(send, 4);
          }
          k1 += __shfl_xor(k1, 2);
          k1 += __shfl_xor(k1, 1);
          if ((lane & 3) == 0) {
            if (dir == 0)
              ys[t * 16 + (lane >> 2)] = k1;
            else
              ys[t * 16 + (lane >> 2)] += k1;
          }
        }
      }
      __syncthreads();
      u16* YG = ws_YG(p);
#pragma unroll
      for (int i = 0; i < 4; ++i) {
        const int id = lane + 64 * i, t = id >> 1, hf = id & 1;
        float u[8], y[8];
        unpack8(*(const u32x4*)(us + t * 16 + hf * 8), u);
        const float* dsk = p.s5_d + jl * 1024 + g * 16 + hf * 8;
#pragma unroll
        for (int e = 0; e < 8; ++e) {
          const float yy = ys[t * 16 + hf * 8 + e] + dsk[e] * u[e];
          y[e] = 0.5f * yy * (1.f + tanhf(0.7978845608028654f * (yy + 0.044715f * yy * yy * yy)));
        }
        *(u32x4*)(YG + (size_t)(b * SPB + seg * 128 + t) * 1024 + g * 16 + hf * 8) = pack8(y);
      }
      __syncthreads();
    }
  }
}

__device__ void phase_odd5(const Params& p, int layer, int bid, int nb, char* smem) {
  const int jl = layer >> 1;
  const int tid = threadIdx.x;
  constexpr int N_GLU = 72 * 8;
  constexpr int N_LRU = 2304;
  EpiGlu epi{p, jl};
  const u16* W = (const u16*)(p.ws + OFF_WGLU) + (size_t)jl * 1024 * 1024;
  const u16* P = ws_P(p);
  for (int item = bid; item < N_GLU + N_LRU; item += nb) {
    if (item < N_GLU) {
      const int mt = item >> 3, nt = item & 7;
      gemm_tile(ws_YG(p), 1024, W, 1024, 1024, mt * 128, nt * 128, smem, epi);
    } else {
      const int it = item - N_GLU;
      const int bc = it >> 2, ch = (it & 3) * 256 + tid;
      const int b = bc / 144, c = bc % 144;
      const int r0 = bc * 16;
      const size_t ci = ((size_t)b * 144 + c) * 1024 + ch;
      const float* LA0 = ws_LA(p) + (size_t)r0 * 1024 + ch;
      const float* LB0 = ws_LB(p) + (size_t)r0 * 1024 + ch;
      const float* LA1 = LA0 + (size_t)ROWS * 1024;
      const float* LB1 = LB0 + (size_t)ROWS * 1024;
      float hf[16];
      float h = ws_CIN(p)[ci];
#pragma unroll
      for (int t = 0; t < 16; ++t) {
        h = LA0[(size_t)t * 1024] * h + LB0[(size_t)t * 1024];
        hf[t] = h;
      }
      h = ws_CIN(p)[(size_t)4 * 144 * 1024 + ci];
#pragma unroll
      for (int tt = 0; tt < 16; ++tt) {
        const int t = 15 - tt;
        h = LA1[(size_t)t * 1024] * h + LB1[(size_t)t * 1024];
        const float gd = bf2f(P[(size_t)(r0 + t) * OD_IN + OGD + ch]);
        ws_MIX(p)[(size_t)(r0 + t) * 2048 + 1024 + ch] = f2bf((hf[t] + h) * gd);
      }
    }
  }
}

__device__ void run_phase(const Params& p, int ph, int bid, int nb, char* smem) {
  if (ph == 0) {
    phase_prep(p, bid, nb, smem);
    return;
  }
  int layer, sub;
  if (ph <= 4) { layer = 0; sub = ph - 1; }
  else if (ph <= 10) { layer = 1; sub = ph - 5; }
  else if (ph <= 14) { layer = 2; sub = ph - 11; }
  else { layer = 3; sub = ph - 15; }
  if ((layer & 1) == 0) {
    if (sub == 0) phase_norm(p, layer, bid, nb);
    else if (sub == 1) phase_gemm_in(p, layer, bid, nb, smem);
    else if (sub == 2) phase_even_mix(p, layer, bid, nb, smem);
    else phase_gemm_out(p, layer, bid, nb, smem);
  } else {
    if (sub == 0) phase_norm(p, layer, bid, nb);
    else if (sub == 1) phase_gemm_in(p, layer, bid, nb, smem);
    else if (sub == 2) phase_odd3(p, layer, bid, nb, smem);
    else if (sub == 3) phase_odd4(p, layer, bid, nb, smem);
    else if (sub == 4) phase_odd5(p, layer, bid, nb, smem);
    else phase_gemm_out(p, layer, bid, nb, smem);
  }
}

#if !MEGA
__global__ void __launch_bounds__(256, 2) k_phase(Params p, int ph) {
  __shared__ __attribute__((aligned(16))) char smem[SMEM_BYTES];
  run_phase(p, ph, blockIdx.x, gridDim.x, smem);
}
#else
__global__ void __launch_bounds__(256, 2) k_mega(Params p) {
  __shared__ __attribute__((aligned(16))) char smem[SMEM_BYTES];
  cg::grid_group grid = cg::this_grid();
  for (int ph = 0; ph < NPHASE; ++ph) {
    run_phase(p, ph, blockIdx.x, gridDim.x, smem);
    if (ph + 1 < NPHASE) grid.sync();
  }
}
#endif

extern "C" void kernel_launch(void* const* d_in, const int* in_sizes, int n_in, void* d_out, int out_size, void* d_ws,
                              size_t ws_size, hipStream_t stream) {
  Params p{};
  const float** pp = (const float**)&p;
  for (int i = 0; i < 33; ++i) pp[i] = (const float*)d_in[i];
  p.out = (float*)d_out;
  p.ws = (char*)d_ws;
  if (ws_size < WS_TOTAL) fprintf(stderr, "workspace too small: %zu < %zu\n", ws_size, (size_t)WS_TOTAL);
  (void)hipMemsetAsync((char*)d_ws + OFF_MODS, 0, SZ_MODS, stream);
#if MEGA
  static int grid_blocks = 0;
  if (!grid_blocks) {
    int dev = 0, cus = 0, per_cu = 0;
    hipGetDevice(&dev);
    hipDeviceGetAttribute(&cus, hipDeviceAttributeMultiprocessorCount, dev);
    hipOccupancyMaxActiveBlocksPerMultiprocessor(&per_cu, k_mega, 256, 0);
    if (per_cu > 2) per_cu = 2;
    grid_blocks = cus * per_cu;
  }
  void* args[] = {&p};
  hipError_t e = hipLaunchCooperativeKernel((void*)k_mega, dim3(grid_blocks), dim3(256), args, 0, stream);
  if (e != hipSuccess) fprintf(stderr, "cooperative launch failed: %s (grid %d)\n", hipGetErrorString(e), grid_blocks);
#else
  for (int ph = 0; ph < NPHASE; ++ph) k_phase<<<1024, 256, 0, stream>>>(p, ph);
#endif
}
```

```cpp
#include <hip/hip_runtime.h>
#include <hip/hip_cooperative_groups.h>
#include <cstdio>
namespace cg = cooperative_groups;

#ifndef MEGA
#define MEGA 1
#endif

typedef unsigned short u16;
typedef unsigned int u32;
using bf16x8 = __attribute__((ext_vector_type(8))) short;
using f32x4 = __attribute__((ext_vector_type(4))) float;
using u32x4 = __attribute__((ext_vector_type(4))) unsigned;
using u32x2 = __attribute__((ext_vector_type(2))) unsigned;
#define DI __device__ __forceinline__
__device__ __forceinline__ int opaque_tid() {
  int t = threadIdx.x;
  asm volatile("" : "+v"(t));
  return t;
}

constexpr int DM = 2048, SPB = 2304, ROWS = 9216;
constexpr int EV_IN = 5632, OD_IN = 4096;
constexpr float EPS = 1e-6f;
constexpr int EQ = 1024, EBU = 2560, EBV = 3072, EGA = 3584, EGB = 5120;
constexpr int OXD = 1024, OGC = 2048, OGD = 3072;
using f32x16 = __attribute__((ext_vector_type(16))) float;
constexpr float ATT_CS = 0.08838834764831845f * 1.4426950408889634f;
constexpr int SMEM_BYTES = 51200;
constexpr int NPHASE = 23;

constexpr size_t al(size_t x) { return (x + 255) & ~size_t(255); }
constexpr size_t OFF_MODS = 0;
constexpr size_t SZ_MODS = (size_t)4 * 5 * 6144 * 4;
constexpr size_t OFF_BAR = al(OFF_MODS + SZ_MODS);
constexpr size_t SZ_BAR = 3456 * 4;
constexpr size_t OFF_X = al(OFF_BAR + SZ_BAR);
constexpr size_t OFF_H = al(OFF_X + (size_t)ROWS * DM * 4);
constexpr size_t OFF_P = al(OFF_H + (size_t)ROWS * DM * 2);
constexpr size_t OFF_MIX = al(OFF_P + (size_t)ROWS * EV_IN * 2);
constexpr size_t OFF_KB = al(OFF_MIX + (size_t)ROWS * DM * 2);
constexpr size_t OFF_VT = al(OFF_KB + (size_t)16 * 2304 * 128 * 2);
constexpr size_t OFF_ROPE = al(OFF_VT + (size_t)16 * 2304 * 128 * 2);
constexpr size_t OFF_WEVIN = al(OFF_ROPE + (size_t)2 * 2048 * 64 * 4);
constexpr size_t OFF_WEVOUT = al(OFF_WEVIN + (size_t)2 * 5632 * 2048 * 2);
constexpr size_t OFF_WODIN = al(OFF_WEVOUT + (size_t)2 * 2048 * 2048 * 2);
constexpr size_t OFF_WODOUT = al(OFF_WODIN + (size_t)2 * 4096 * 2048 * 2);
constexpr size_t OFF_WGLU = al(OFF_WODOUT + (size_t)2 * 2048 * 2048 * 2);
constexpr size_t OFF_YG = al(OFF_WGLU + (size_t)2 * 1024 * 1024 * 2);
constexpr size_t OFF_E = al(OFF_YG + (size_t)ROWS * 1024 * 2);
constexpr size_t OFF_LA = al(OFF_E + (size_t)2 * 4 * 64 * 18 * 64 * 2 * 4);
constexpr size_t OFF_LB = al(OFF_LA + (size_t)2 * ROWS * 1024 * 4);
constexpr size_t OFF_SA = al(OFF_LB + (size_t)2 * ROWS * 1024 * 4);
constexpr size_t OFF_SB = al(OFF_SA + (size_t)2 * 4 * 144 * 1024 * 4);
constexpr size_t OFF_CIN = al(OFF_SB + (size_t)2 * 4 * 144 * 1024 * 4);
constexpr size_t OFF_BVT = al(OFF_CIN + (size_t)2 * 4 * 144 * 1024 * 4);
constexpr size_t OFF_WSB = al(OFF_BVT + (size_t)72 * 4 * 128 * 128 * 2);
constexpr size_t OFF_WLRU = al(OFF_WSB + (size_t)2 * 4 * 128 * 128 * 2);
constexpr size_t OFF_C8 = al(OFF_WLRU + (size_t)2 * 8 * 512 * 128 * 2);
constexpr size_t OFF_XC = al(OFF_C8 + (size_t)4096 * 4);
constexpr size_t OFF_S5T = al(OFF_XC + (size_t)ROWS * 1024 * 2);
constexpr int S5T_WORDS = 128 + 8 * 64 * 4 + 4 * 64 * 4;
constexpr size_t WS_TOTAL = al(OFF_S5T + (size_t)256 * S5T_WORDS * 4);

struct Params {
  const float *x, *c, *ctx, *c_ctx, *ada_w, *ada_b, *norm_g, *ev_w_in, *ev_w_out, *ev_q_g, *ev_k_g, *ev_sgu_g, *ev_ws,
      *ev_bs, *od_w_in, *od_w_out, *s5_lam_re, *s5_lam_im, *s5_log_dt, *s5_b_re, *s5_b_im, *s5_c_re, *s5_c_im, *s5_d,
      *s5_glu_w, *s5_glu_b, *lru_conv_w, *lru_conv_b, *lru_lam, *lru_wa, *lru_ba, *lru_wx, *lru_bx;
  float* out;
  char* ws;
};

DI u16 f2bf(float x) {
  u32 u = __float_as_uint(x);
  u += 0x7fffu + ((u >> 16) & 1u);
  return (u16)(u >> 16);
}
DI float bf2f(u16 v) { return __uint_as_float(((u32)v) << 16); }
DI float blo(u32 v) { return __uint_as_float(v << 16); }
DI float bhi(u32 v) { return __uint_as_float(v & 0xffff0000u); }
DI u32 pk(float a, float b) { return (u32)f2bf(a) | ((u32)f2bf(b) << 16); }
DI float sigmoidf_(float x) { return 1.f / (1.f + __expf(-x)); }
DI float siluf_(float x) { return x / (1.f + __expf(-x)); }
DI float red16(float v) {
  v += __shfl_xor(v, 1);
  v += __shfl_xor(v, 2);
  v += __shfl_xor(v, 4);
  v += __shfl_xor(v, 8);
  return v;
}
DI float wave_sum(float v) {
  v = red16(v);
  v += __shfl_xor(v, 16);
  v += __shfl_xor(v, 32);
  return v;
}
DI float wave_max(float v) {
#pragma unroll
  for (int o = 1; o < 64; o <<= 1) v = fmaxf(v, __shfl_xor(v, o));
  return v;
}
DI void unpack8(u32x4 q, float* v) {
#pragma unroll
  for (int e = 0; e < 4; ++e) {
    v[2 * e] = blo(q[e]);
    v[2 * e + 1] = bhi(q[e]);
  }
}
DI u32x4 pack8(const float* v) {
  u32x4 q;
#pragma unroll
  for (int e = 0; e < 4; ++e) q[e] = pk(v[2 * e], v[2 * e + 1]);
  return q;
}

DI float* ws_mods(const Params& p) { return (float*)(p.ws + OFF_MODS); }
DI float* ws_X(const Params& p) { return (float*)(p.ws + OFF_X); }
DI u16* ws_H(const Params& p) { return (u16*)(p.ws + OFF_H); }
DI u16* ws_P(const Params& p) { return (u16*)(p.ws + OFF_P); }
DI u16* ws_MIX(const Params& p) { return (u16*)(p.ws + OFF_MIX); }
DI u16* ws_KB(const Params& p) { return (u16*)(p.ws + OFF_KB); }
DI u16* ws_VT(const Params& p) { return (u16*)(p.ws + OFF_VT); }
DI float* ws_ROPE(const Params& p) { return (float*)(p.ws + OFF_ROPE); }
DI u16* ws_YG(const Params& p) { return (u16*)(p.ws + OFF_YG); }
DI float* ws_E(const Params& p) { return (float*)(p.ws + OFF_E); }
DI float* ws_LA(const Params& p) { return (float*)(p.ws + OFF_LA); }
DI float* ws_LB(const Params& p) { return (float*)(p.ws + OFF_LB); }
DI float* ws_SA(const Params& p) { return (float*)(p.ws + OFF_SA); }
DI float* ws_SB(const Params& p) { return (float*)(p.ws + OFF_SB); }
DI float* ws_CIN(const Params& p) { return (float*)(p.ws + OFF_CIN); }

DI void s5_table_store(const Params& p, int jl, int dir, int g, int lane);
__device__ void phase_prep(const Params& p, int bid, int nb, char* smem) {
  const int tid = opaque_tid();
  constexpr int N_ADA = 4 * 24 * 16;
  constexpr int T_EVIN = 2 * 32 * 88, T_EVOUT = 2 * 32 * 32, T_ODIN = 2 * 32 * 64, T_ODOUT = 2 * 32 * 32,
                T_GLU = 2 * 16 * 16, T_LRU = 2 * 32 * 4;
  constexpr int N_TR = T_EVIN + T_EVOUT + T_ODIN + T_ODOUT + T_GLU + T_LRU;
  constexpr int N_ROPE = 512;
  constexpr int N_WSB = 64;
  constexpr int N_C8 = 16;
  constexpr int N_S5T = 64;
  float* sf = (float*)smem;
  for (int item0 = bid; item0 < N_ADA + N_TR + N_ROPE + N_WSB + N_C8 + N_S5T; item0 += nb) {
    int item = item0;
    if (item0 < 10 * N_ADA) item = (item0 % 10 == 0) ? item0 / 10 : N_ADA + item0 - item0 / 10 - 1;
    if (item < N_ADA) {
      const int l = item / 384, rem = item % 384, cb = rem / 16, kc = rem % 16;
      const int n = cb * 256 + tid;
      if (tid < 128) {
#pragma unroll
        for (int i = 0; i < 5; ++i) {
          float cv = (i < 4) ? p.c[i * 2048 + kc * 128 + tid] : p.c_ctx[kc * 128 + tid];
          sf[i * 128 + tid] = cv / (1.f + expf(-cv));
        }
      }
      __syncthreads();
      float acc[5] = {0.f, 0.f, 0.f, 0.f, 0.f};
      const float* w = p.ada_w + ((size_t)l * 2048 + kc * 128) * 6144 + n;
#pragma unroll 8
      for (int k = 0; k < 128; ++k) {
        float wv = __builtin_nontemporal_load(w + (size_t)k * 6144);
#pragma unroll
        for (int i = 0; i < 5; ++i) acc[i] += sf[i * 128 + k] * wv;
      }
      float bias = (kc == 0) ? p.ada_b[l * 6144 + n] : 0.f;
      float* mods = ws_mods(p);
#pragma unroll
      for (int i = 0; i < 5; ++i) atomicAdd(&mods[(size_t)(l * 5 + i) * 6144 + n], acc[i] + bias);
      __syncthreads();
    } else if (item < N_ADA + N_TR) {
      int t = item - N_ADA;
      const float* src;
      u16* dst;
      int K, N;
      bool lru = false;
      int lru_type = 0;
      if (t < T_EVIN) {
        K = 2048; N = 5632; src = p.ev_w_in; dst = (u16*)(p.ws + OFF_WEVIN);
      } else if ((t -= T_EVIN) < T_EVOUT) {
        K = 2048; N = 2048; src = p.ev_w_out; dst = (u16*)(p.ws + OFF_WEVOUT);
      } else if ((t -= T_EVOUT) < T_ODIN) {
        K = 2048; N = 4096; src = p.od_w_in; dst = (u16*)(p.ws + OFF_WODIN);
      } else if ((t -= T_ODIN) < T_ODOUT) {
        K = 2048; N = 2048; src = p.od_w_out; dst = (u16*)(p.ws + OFF_WODOUT);
      } else if ((t -= T_ODOUT) < T_GLU) {
        K = 1024; N = 1024; src = p.s5_glu_w; dst = (u16*)(p.ws + OFF_WGLU);
      } else {
        t -= T_GLU;
        K = 128; N = 128;
        lru = true;
        src = (t < 128) ? p.lru_wa : p.lru_wx;
        dst = (u16*)(p.ws + OFF_WLRU);
        lru_type = (t < 128) ? 0 : 1;
        t &= 127;
      }
      const int ntn = N / 64, tpm = (K / 64) * ntn;
      const int mat = t / tpm, tt = t % tpm, kt = tt / ntn, nt = tt % ntn;
      src += (size_t)mat * K * N;
      if (!lru) dst += (size_t)mat * K * N;
      else {
        const int jl_ = mat >> 4, dir_ = (mat >> 3) & 1, h_ = mat & 7;
        dst += ((size_t)(jl_ * 8 + h_) * 512 + dir_ * 256 + 4 * lru_type) * 128;
      }
#pragma unroll
      for (int i = 0; i < 16; ++i) {
        int k = i * 4 + (tid >> 6), n = tid & 63;
        sf[k * 65 + n] = __builtin_nontemporal_load(src + (size_t)(kt * 64 + k) * N + nt * 64 + n);
      }
      __syncthreads();
      {
        const int n = tid >> 2, ks = (tid & 3) * 16;
        float v[16];
#pragma unroll
        for (int j = 0; j < 16; ++j) v[j] = sf[(ks + j) * 65 + n];
        const int nn = nt * 64 + n;
        const int drow = lru ? (8 * (nn >> 2) + (nn & 3)) : nn;
        u32x4* d = (u32x4*)(dst + (size_t)drow * K + kt * 64 + ks);
        d[0] = pack8(v);
        d[1] = pack8(v + 8);
      }
      __syncthreads();
    } else if (item >= N_ADA + N_TR + N_ROPE + N_WSB + N_C8) {
      const int e = (item - N_ADA - N_TR - N_ROPE - N_WSB - N_C8) * 4 + (tid >> 6);
      s5_table_store(p, e >> 7, (e >> 6) & 1, e & 63, tid & 63);
    } else if (item >= N_ADA + N_TR + N_ROPE + N_WSB) {
      const int idx = (item - N_ADA - N_TR - N_ROPE - N_WSB) * 256 + tid;
      ((float*)(p.ws + OFF_C8))[idx] = -8.f * log1pf(expf(-p.lru_lam[idx]));
    } else if (item >= N_ADA + N_TR + N_ROPE) {
      const int idx = ((item - N_ADA - N_TR - N_ROPE) * 256 + tid) * 8;
      float v[8];
      const f32x4 a0 = *(const f32x4*)(p.ev_ws + idx), a1 = *(const f32x4*)(p.ev_ws + idx + 4);
      v[0] = a0[0]; v[1] = a0[1]; v[2] = a0[2]; v[3] = a0[3];
      v[4] = a1[0]; v[5] = a1[1]; v[6] = a1[2]; v[7] = a1[3];
      *(u32x4*)((u16*)(p.ws + OFF_WSB) + idx) = pack8(v);
    } else {
      const int idx = (item - N_ADA - N_TR) * 256 + tid;
      const int i = idx & 63, tok = idx >> 6;
      const int row = tok >> 6, col = tok & 63, m = i & 31;
      const float pos = (float)((i < 32) ? row : col);
      const float inv = powf(10000.f, -(float)(2 * m) / 64.f);
      const float ang = pos * inv;
      float* rp = ws_ROPE(p);
      rp[idx] = cosf(ang);
      rp[2048 * 64 + idx] = sinf(ang);
    }
  }
}

__device__ void phase_norm(const Params& p, int layer, int bid, int nb) {
  const int lane = opaque_tid() & 63, wave = opaque_tid() >> 6;
  float* X = ws_X(p);
  u16* H = ws_H(p);
  const float* g = p.norm_g + layer * 2048;
  for (int item = bid; item < ROWS / 4; item += nb) {
    const int r = item * 4 + wave;
    const int b = r / SPB, s = r % SPB;
    const float* src;
    if (layer == 0)
      src = (s < 256) ? p.ctx + ((size_t)b * 256 + s) * 2048 : p.x + ((size_t)b * 2048 + (s - 256)) * 2048;
    else
      src = X + (size_t)r * 2048;
    const int mi = (s < 256) ? 4 : b;
    const float* md = ws_mods(p) + (size_t)(layer * 5 + mi) * 6144;
    f32x4 v[8];
    float ss = 0.f;
#pragma unroll
    for (int i = 0; i < 8; ++i) {
      v[i] = *(const f32x4*)(src + (i * 64 + lane) * 4);
      ss += v[i][0] * v[i][0] + v[i][1] * v[i][1] + v[i][2] * v[i][2] + v[i][3] * v[i][3];
    }
    ss = wave_sum(ss);
    const float rstd = rsqrtf(ss * (1.f / 2048.f) + EPS);
#pragma unroll
    for (int i = 0; i < 8; ++i) {
      const int c = (i * 64 + lane) * 4;
      f32x4 gv = *(const f32x4*)(g + c);
      f32x4 sh = *(const f32x4*)(md + c);
      f32x4 sc = *(const f32x4*)(md + 2048 + c);
      float h0 = v[i][0] * rstd * gv[0] * (1.f + sc[0]) + sh[0];
      float h1 = v[i][1] * rstd * gv[1] * (1.f + sc[1]) + sh[1];
      float h2 = v[i][2] * rstd * gv[2] * (1.f + sc[2]) + sh[2];
      float h3 = v[i][3] * rstd * gv[3] * (1.f + sc[3]) + sh[3];
      u32x2 o;
      o[0] = pk(h0, h1);
      o[1] = pk(h2, h3);
      *(u32x2*)(H + (size_t)r * 2048 + c) = o;
      if (layer == 0) *(f32x4*)(X + (size_t)r * 2048 + c) = v[i];
    }
  }
}

constexpr int LST = 64;

struct PlainA {
  static constexpr bool kDma = true;
  const u16* A;
  int lda;
  DI u32x4 load(int row, int k) const { return *(const u32x4*)(A + (size_t)row * lda + k); }
};

template <class AL, class Epi>
DI void gemm_tile(const AL& al, int arow0, const u16* __restrict__ Bt, int ldb, int brow0, int K, int m0, int n0,
                  char* smem, Epi& epi) {
  u16* sA = (u16*)smem;
  u16* sB = sA + 128 * LST;
  const int tid = opaque_tid(), lane = tid & 63, wave = tid >> 6, wm = wave >> 1, wn = wave & 1;
  const int fr = lane & 15, fq = lane >> 4;
  f32x4 acc[4][4];
#pragma unroll
  for (int i = 0; i < 4; ++i)
#pragma unroll
    for (int j = 0; j < 4; ++j) acc[i][j] = f32x4{0.f, 0.f, 0.f, 0.f};
  const int lrow = tid >> 3, lkc = (tid & 7) * 8;
  const int lkw = ((tid & 7) ^ (lrow & 7)) * 8;
  const u16* Bg = Bt + (size_t)(brow0 + lrow) * ldb + lkc;
  if constexpr (AL::kDma) {
    const int wv = __builtin_amdgcn_readfirstlane(tid >> 6);
    const int fsw = (4 - ((lane >> 4) & 3)) & 3;
    const int lch = ((lane & 3) ^ fsw) * 8;
    const u16* ag0 = al.A + (size_t)(arow0 + 32 * wv + (lane >> 2)) * al.lda + lch;
    const u16* ag1 = ag0 + (size_t)16 * al.lda;
    const u16* bg0 = Bt + (size_t)(brow0 + 32 * wv + (lane >> 2)) * ldb + lch;
    const u16* bg1 = bg0 + (size_t)16 * ldb;
    char* lbase = smem + wv * 2048;
    const int rsw = (4 - ((fr >> 2) & 3)) & 3;
    const int rdo = (fq ^ rsw) << 3;
    const int nk = K >> 5;
    const unsigned lds0 = (unsigned)(size_t)smem;
    const unsigned offA = (unsigned)(((wm * 64 + fr) * 32 + rdo) * 2), offB = (unsigned)(((wn * 64 + fr) * 32 + rdo) * 2);
#define GLDS(KT, ST)                                                                                              \
  {                                                                                                               \
    char* d_ = lbase + (ST) * 16384;                                                                              \
    __builtin_amdgcn_global_load_lds((const u32*)(ag0 + (KT) * 32), (u32*)(d_), 16, 0, 0);                        \
    __builtin_amdgcn_global_load_lds((const u32*)(ag1 + (KT) * 32), (u32*)(d_ + 1024), 16, 0, 0);                 \
    __builtin_amdgcn_global_load_lds((const u32*)(bg0 + (KT) * 32), (u32*)(d_ + 8192), 16, 0, 0);                 \
    __builtin_amdgcn_global_load_lds((const u32*)(bg1 + (KT) * 32), (u32*)(d_ + 8192 + 1024), 16, 0, 0);          \
  }
    __syncthreads();
    GLDS(0, 0);
    GLDS(1, 1);
    int st = 0;
    for (int kt = 0; kt < nk; ++kt) {
      if (kt + 1 < nk) asm volatile("s_waitcnt vmcnt(4)" ::: "memory");
      else asm volatile("s_waitcnt vmcnt(0)" ::: "memory");
      asm volatile("s_waitcnt lgkmcnt(0)" ::: "memory");
      __builtin_amdgcn_s_barrier();
      if (kt + 2 < nk) {
        const int st2 = (st >= 1) ? st - 1 : 2;
        GLDS(kt + 2, st2);
      }
      const unsigned adA = lds0 + st * 16384 + offA, adB = lds0 + st * 16384 + offB;
      bf16x8 af0, af1, af2, af3, bf0, bf1, bf2, bf3;
      asm volatile(
          "ds_read_b128 %0, %8\n\t"
          "ds_read_b128 %1, %8 offset:1024\n\t"
          "ds_read_b128 %2, %8 offset:2048\n\t"
          "ds_read_b128 %3, %8 offset:3072\n\t"
          "ds_read_b128 %4, %9 offset:8192\n\t"
          "ds_read_b128 %5, %9 offset:9216\n\t"
          "ds_read_b128 %6, %9 offset:10240\n\t"
          "ds_read_b128 %7, %9 offset:11264\n\t"
          "s_waitcnt lgkmcnt(0)"
          : "=&v"(af0), "=&v"(af1), "=&v"(af2), "=&v"(af3), "=&v"(bf0), "=&v"(bf1), "=&v"(bf2), "=&v"(bf3)
          : "v"(adA), "v"(adB)
          : "memory");
      const bf16x8 af[4] = {af0, af1, af2, af3};
      const bf16x8 bfr[4] = {bf0, bf1, bf2, bf3};
#pragma unroll
      for (int i = 0; i < 4; ++i)
#pragma unroll
        for (int j = 0; j < 4; ++j) acc[i][j] = __builtin_amdgcn_mfma_f32_16x16x32_bf16(af[i], bfr[j], acc[i][j], 0, 0, 0);
      st = (st == 2) ? 0 : st + 1;
    }
#undef GLDS
  } else {
  u32x4 ra0[4], rb0[4], ra1[4], rb1[4];
#pragma unroll
  for (int i = 0; i < 4; ++i) {
    ra0[i] = al.load(arow0 + lrow + i * 32, lkc);
    rb0[i] = *(const u32x4*)(Bg + (size_t)(i * 32) * ldb);
  }
#pragma unroll
  for (int i = 0; i < 4; ++i) {
    ra1[i] = al.load(arow0 + lrow + i * 32, 64 + lkc);
    rb1[i] = *(const u32x4*)(Bg + (size_t)(i * 32) * ldb + 64);
  }
  const int swz = (fr & 7);
#define GEMM_COMPUTE()                                                                                              \
  {                                                                                                                 \
    bf16x8 af[2][4], bfr[2][4];                                                                                     \
    _Pragma("unroll") for (int ks = 0; ks < 2; ++ks) {                                                              \
      _Pragma("unroll") for (int i = 0; i < 4; ++i) af[ks][i] =                                                     \
          *(const bf16x8*)(sA + (wm * 64 + i * 16 + fr) * LST + (((ks * 4 + fq) ^ swz) << 3));                      \
      _Pragma("unroll") for (int j = 0; j < 4; ++j) bfr[ks][j] =                                                    \
          *(const bf16x8*)(sB + (wn * 64 + j * 16 + fr) * LST + (((ks * 4 + fq) ^ swz) << 3));                      \
    }                                                                                                               \
    _Pragma("unroll") for (int ks = 0; ks < 2; ++ks)                                                                \
    _Pragma("unroll") for (int i = 0; i < 4; ++i) _Pragma("unroll") for (int j = 0; j < 4; ++j) acc[i][j] =         \
        __builtin_amdgcn_mfma_f32_16x16x32_bf16(af[ks][i], bfr[ks][j], acc[i][j], 0, 0, 0);                         \
  }
  for (int k0 = 0; k0 < K; k0 += 128) {
    __syncthreads();
#pragma unroll
    for (int i = 0; i < 4; ++i) {
      *(u32x4*)(sA + (lrow + i * 32) * LST + lkw) = ra0[i];
      *(u32x4*)(sB + (lrow + i * 32) * LST + lkw) = rb0[i];
    }
    __syncthreads();
    if (k0 + 128 < K) {
#pragma unroll
      for (int i = 0; i < 4; ++i) {
        ra0[i] = al.load(arow0 + lrow + i * 32, k0 + 128 + lkc);
        rb0[i] = *(const u32x4*)(Bg + (size_t)(i * 32) * ldb + k0 + 128);
      }
    }
    GEMM_COMPUTE();
    __syncthreads();
#pragma unroll
    for (int i = 0; i < 4; ++i) {
      *(u32x4*)(sA + (lrow + i * 32) * LST + lkw) = ra1[i];
      *(u32x4*)(sB + (lrow + i * 32) * LST + lkw) = rb1[i];
    }
    __syncthreads();
    if (k0 + 192 < K) {
#pragma unroll
      for (int i = 0; i < 4; ++i) {
        ra1[i] = al.load(arow0 + lrow + i * 32, k0 + 192 + lkc);
        rb1[i] = *(const u32x4*)(Bg + (size_t)(i * 32) * ldb + k0 + 192);
      }
    }
    GEMM_COMPUTE();
  }
#undef GEMM_COMPUTE
  }
  float* T = (float*)smem;
  const int mode = epi.mode(n0);
  const bool tr = (mode == 1);
#pragma unroll
  for (int half = 0; half < 2; ++half) {
    __syncthreads();
    if (wm == half) {
      if (!tr) {
#pragma unroll
        for (int i = 0; i < 4; ++i)
#pragma unroll
          for (int j = 0; j < 4; ++j)
#pragma unroll
            for (int e = 0; e < 4; ++e) T[(i * 16 + fq * 4 + e) * 132 + wn * 64 + j * 16 + fr] = acc[i][j][e];
      } else {
#pragma unroll
        for (int i = 0; i < 4; ++i)
#pragma unroll
          for (int j = 0; j < 4; ++j) *(f32x4*)(T + (wn * 64 + j * 16 + fr) * 68 + i * 16 + fq * 4) = acc[i][j];
      }
    }
    __syncthreads();
    if (!tr) {
#pragma unroll
      for (int pass = 0; pass < 4; ++pass) {
        const int lr = pass * 16 + (tid >> 4), c0 = (tid & 15) * 8;
        float v[8];
        f32x4 t0 = *(const f32x4*)(T + lr * 132 + c0), t1 = *(const f32x4*)(T + lr * 132 + c0 + 4);
        v[0] = t0[0]; v[1] = t0[1]; v[2] = t0[2]; v[3] = t0[3];
        v[4] = t1[0]; v[5] = t1[1]; v[6] = t1[2]; v[7] = t1[3];
        epi.row(m0 + half * 64 + lr, n0 + c0, v);
        if (mode == 2) {
          f32x4 w0, w1;
          w0[0] = v[0]; w0[1] = v[1]; w0[2] = v[2]; w0[3] = v[3];
          w1[0] = v[4]; w1[1] = v[5]; w1[2] = v[6]; w1[3] = v[7];
          *(f32x4*)(T + lr * 132 + c0) = w0;
          *(f32x4*)(T + lr * 132 + c0 + 4) = w1;
        }
      }
      if (mode == 2) {
        __syncthreads();
        epi.post(T, m0 + half * 64, n0);
      }
    } else {
#pragma unroll
      for (int pass = 0; pass < 4; ++pass) {
        const int lc = pass * 32 + (tid >> 3), r0 = (tid & 7) * 8;
        float v[8];
        f32x4 t0 = *(const f32x4*)(T + lc * 68 + r0), t1 = *(const f32x4*)(T + lc * 68 + r0 + 4);
        v[0] = t0[0]; v[1] = t0[1]; v[2] = t0[2]; v[3] = t0[3];
        v[4] = t1[0]; v[5] = t1[1]; v[6] = t1[2]; v[7] = t1[3];
        epi.col(n0 + lc, m0 + half * 64 + r0, v);
      }
    }
  }
}

struct EpiEvenIn {
  const Params& p;
  int j;
  DI int mode(int n0) const {
    const int nt = n0 >> 7;
    return (nt >= 4 && nt < 8) ? 1 : ((nt >= 24 && nt < 28) ? 2 : 0);
  }
  DI void row(int r, int c, float* v) const {
    const int nt = c >> 7, cc = c & 127;
    const int b = r / SPB, s = r % SPB;
    u16* dst = ws_P(p) + (size_t)r * EV_IN + c;
    if (nt < 4 || (nt >= 8 && nt < 20)) {
      float ss = 0.f;
#pragma unroll
      for (int e = 0; e < 8; ++e) ss += v[e] * v[e];
      ss = red16(ss);
      const float rstd = rsqrtf(ss * (1.f / 128.f) + EPS);
      const float* g = ((nt < 4) ? p.ev_k_g : p.ev_q_g) + j * 128 + cc;
#pragma unroll
      for (int e = 0; e < 8; ++e) v[e] = v[e] * rstd * g[e];
      if (s >= 256) {
        const int tok = s - 256;
        const float* rc = ws_ROPE(p) + tok * 64 + (cc >> 1);
        const float* rs = rc + 2048 * 64;
#pragma unroll
        for (int e = 0; e < 4; ++e) {
          const float cs = rc[e], sn = rs[e];
          const float x0 = v[2 * e], x1 = v[2 * e + 1];
          v[2 * e] = x0 * cs - x1 * sn;
          v[2 * e + 1] = x0 * sn + x1 * cs;
        }
      }
      if (nt < 4) dst = ws_KB(p) + ((size_t)(b * 4 + nt) * 2304 + s) * 128 + cc;
      else {
#pragma unroll
        for (int e = 0; e < 8; ++e) v[e] *= ATT_CS;
      }
    } else if (nt >= 24 && nt < 28) {
      float ss = 0.f;
#pragma unroll
      for (int e = 0; e < 8; ++e) ss += v[e] * v[e];
      ss = red16(ss);
      const float rstd = rsqrtf(ss * (1.f / 128.f) + EPS);
      const float* g = p.ev_sgu_g + j * 512 + (nt - 24) * 128 + cc;
#pragma unroll
      for (int e = 0; e < 8; ++e) v[e] = v[e] * rstd * g[e];
      return;
    } else if (nt >= 28) {
#pragma unroll
      for (int e = 0; e < 8; ++e) v[e] = siluf_(v[e]);
    }
    *(u32x4*)dst = pack8(v);
  }
  DI void post(float* T, int mrow0, int n0) const {
    const int tid = opaque_tid();
    const int g = (n0 >> 7) - 24, chunk = mrow0 >> 7, roff = mrow0 & 127;
    u16* dst = (u16*)(p.ws + OFF_BVT) + (size_t)(chunk * 4 + g) * 128 * 128;
#pragma unroll
    for (int pass = 0; pass < 4; ++pass) {
      const int lc = pass * 32 + (tid >> 3), r0 = (tid & 7) * 8;
      float v[8];
#pragma unroll
      for (int e = 0; e < 8; ++e) v[e] = T[(r0 + e) * 132 + lc];
      *(u32x4*)(dst + lc * 128 + roff + r0) = pack8(v);
    }
  }
  DI void col(int c, int r0, float* v) const {
    const int kvh = (c >> 7) - 4, d = c & 127;
    const int b = r0 / SPB, s = r0 % SPB;
    *(u32x4*)(ws_VT(p) + ((size_t)(b * 4 + kvh) * 128 + d) * 2304 + s) = pack8(v);
  }
};

struct EpiOddIn {
  const Params& p;
  DI int mode(int) const { return 0; }
  DI void post(float*, int, int) const {}
  DI void row(int r, int c, float* v) const {
    if (c >= OGC) {
#pragma unroll
      for (int e = 0; e < 8; ++e) v[e] = siluf_(v[e]);
    }
    *(u32x4*)(ws_P(p) + (size_t)r * OD_IN + c) = pack8(v);
  }
  DI void col(int, int, float*) const {}
};

struct EpiOut {
  const Params& p;
  int layer;
  DI int mode(int) const { return 0; }
  DI void post(float*, int, int) const {}
  DI void row(int r, int c, float* v) const {
    const int b = r / SPB, s = r % SPB;
    const int mi = (s < 256) ? 4 : b;
    const float* gate = ws_mods(p) + (size_t)(layer * 5 + mi) * 6144 + 4096 + c;
    float* xp = ws_X(p) + (size_t)r * 2048 + c;
    f32x4 x0 = __builtin_nontemporal_load((const f32x4*)xp), x1 = __builtin_nontemporal_load((const f32x4*)(xp + 4));
    f32x4 g0 = *(const f32x4*)gate, g1 = *(const f32x4*)(gate + 4);
#pragma unroll
    for (int e = 0; e < 4; ++e) {
      x0[e] += g0[e] * v[e];
      x1[e] += g1[e] * v[4 + e];
    }
    if (layer == 3) {
      if (s >= 256) {
        float* o = p.out + ((size_t)b * 2048 + (s - 256)) * 2048 + c;
        __builtin_nontemporal_store(x0, (f32x4*)o);
        __builtin_nontemporal_store(x1, (f32x4*)(o + 4));
      }
    } else {
      *(f32x4*)xp = x0;
      *(f32x4*)(xp + 4) = x1;
    }
  }
  DI void col(int, int, float*) const {}
};

struct EpiGlu {
  const Params& p;
  int j;
  DI int mode(int) const { return 0; }
  DI void post(float*, int, int) const {}
  DI void row(int r, int c, float* v) const {
    float yg[8], gc[8];
    unpack8(*(const u32x4*)(ws_YG(p) + (size_t)r * 1024 + c), yg);
    unpack8(*(const u32x4*)(ws_P(p) + (size_t)r * OD_IN + OGC + c), gc);
    const float* gb = p.s5_glu_b + j * 1024 + c;
#pragma unroll
    for (int e = 0; e < 8; ++e) v[e] = yg[e] * sigmoidf_(v[e] + gb[e]) * gc[e];
    *(u32x4*)(ws_MIX(p) + (size_t)r * 2048 + c) = pack8(v);
  }
  DI void col(int, int, float*) const {}
};

struct EpiSgu {
  const Params& p;
  int j;
  DI int mode(int) const { return 0; }
  DI void post(float*, int, int) const {}
  DI void row(int r, int c, float* v) const {
    const u16* P = ws_P(p);
    const float bsv = p.ev_bs[(j * 4 + (c >> 7)) * 128 + (r & 127)];
    float u[8], gb[8];
    unpack8(*(const u32x4*)(P + (size_t)r * EV_IN + EBU + c), u);
    unpack8(*(const u32x4*)(P + (size_t)r * EV_IN + EGB + c), gb);
#pragma unroll
    for (int e = 0; e < 8; ++e) v[e] = u[e] * (v[e] + bsv) * gb[e];
    *(u32x4*)(ws_MIX(p) + (size_t)r * 2048 + 1536 + c) = pack8(v);
  }
  DI void col(int, int, float*) const {}
};

struct ConvA {
  static constexpr bool kDma = false;
  const Params& p;
  int jl, h;
  const u16* A = nullptr;
  int lda = 0;
  DI void conv8(int r, int ch, float* a) const {
    const int b = r / SPB, s = r % SPB;
    const int lo = (s < 256) ? 0 : 256, hi = (s < 256) ? 256 : 2304;
    const u16* P = ws_P(p);
    const f32x4 b0 = *(const f32x4*)(p.lru_conv_b + jl * 1024 + ch), b1 = *(const f32x4*)(p.lru_conv_b + jl * 1024 + ch + 4);
    a[0] = b0[0]; a[1] = b0[1]; a[2] = b0[2]; a[3] = b0[3];
    a[4] = b1[0]; a[5] = b1[1]; a[6] = b1[2]; a[7] = b1[3];
#pragma unroll
    for (int kk = 0; kk < 4; ++kk) {
      const int ss = s + kk - 1;
      if (ss >= lo && ss < hi) {
        float x[8];
        unpack8(*(const u32x4*)(P + (size_t)(b * SPB + ss) * OD_IN + OXD + ch), x);
        const float* w = p.lru_conv_w + (jl * 4 + kk) * 1024 + ch;
        const f32x4 w0 = *(const f32x4*)w, w1 = *(const f32x4*)(w + 4);
        a[0] += w0[0] * x[0]; a[1] += w0[1] * x[1]; a[2] += w0[2] * x[2]; a[3] += w0[3] * x[3];
        a[4] += w1[0] * x[4]; a[5] += w1[1] * x[5]; a[6] += w1[2] * x[6]; a[7] += w1[3] * x[7];
      }
    }
  }
  DI u32x4 load(int row, int k) const {
    float a[8];
    conv8(row, h * 128 + k, a);
    return pack8(a);
  }
};

struct EpiLru {
  const Params& p;
  int jl, h;
  DI int mode(int) const { return 2; }
  DI void row(int r, int c, float* v) const {
    const int dir = c >> 8, j0 = ((c & 255) >> 3) * 4;
    const int ch = h * 128 + j0;
    float xc[8];
    {
      const u32x2 xq = *(const u32x2*)((const u16*)(p.ws + OFF_XC) + (size_t)r * 1024 + ch);
      xc[0] = blo(xq[0]); xc[1] = bhi(xq[0]); xc[2] = blo(xq[1]); xc[3] = bhi(xq[1]);
    }
    const int xo = 0;
    const int pi = (jl * 2 + dir) * 1024 + ch;
    const f32x4 ba = *(const f32x4*)(p.lru_ba + pi), bx = *(const f32x4*)(p.lru_bx + pi);
    const f32x4 c8 = *(const f32x4*)((const float*)(p.ws + OFF_C8) + pi);
    f32x4 av, bv;
#pragma unroll
    for (int e = 0; e < 4; ++e) {
      const float rg = __builtin_amdgcn_rcpf(1.f + __expf(-(v[e] + ba[e])));
      const float ig = __builtin_amdgcn_rcpf(1.f + __expf(-(v[4 + e] + bx[e])));
      const float la = c8[e] * rg;
      av[e] = __expf(la);
      const float x = 2.f * la;
      const float om = -x * (1.f + x * (0.5f + x * (0.16666667f + x * (0.041666668f + x * (0.008333334f + x * 0.0013888889f)))));
      bv[e] = __builtin_amdgcn_sqrtf(om) * (ig * xc[xo + e]);
    }
    __builtin_nontemporal_store(av, (f32x4*)(ws_LA(p) + ((size_t)dir * ROWS + r) * 1024 + ch));
    __builtin_nontemporal_store(bv, (f32x4*)(ws_LB(p) + ((size_t)dir * ROWS + r) * 1024 + ch));
#pragma unroll
    for (int e = 0; e < 4; ++e) {
      v[e] = av[e];
      v[4 + e] = bv[e];
    }
  }
  DI void post(float* T, int mrow0, int n0) const {
    const int tid = opaque_tid();
    const int dir = n0 >> 8, jhalf = (n0 >> 7) & 1;
    const int cq = tid >> 6, jj = tid & 63;
    const int ca = 8 * (jj >> 2) + (jj & 3);
    float Ap = 1.f, Bp = 0.f;
#pragma unroll
    for (int k = 0; k < 16; ++k) {
      const int rr = cq * 16 + (dir ? 15 - k : k);
      const float a = T[rr * 132 + ca], b = T[rr * 132 + ca + 4];
      Bp = a * Bp + b;
      Ap *= a;
    }
    const int b_ = mrow0 / SPB, chunk = (mrow0 % SPB) / 16 + cq;
    const size_t si = (((size_t)dir * 4 + b_) * 144 + chunk) * 1024 + h * 128 + jhalf * 64 + jj;
    ws_SA(p)[si] = Ap;
    ws_SB(p)[si] = Bp;
  }
  DI void col(int, int, float*) const {}
};

DI void tile_remap(int item, int nb, int total, int NT, int& mt, int& nt) {
  int v = item;
  if ((nb & 7) == 0) {
    const int k = item / nb;
    if (k < total / nb) {
      const int bid = item % nb;
      v = k * nb + (bid & 7) * (nb >> 3) + (bid >> 3);
    }
  }
  const int q = v >> 5, t = v & 31, nrn = NT >> 2;
  mt = (q / nrn) * 8 + (t >> 2);
  nt = (q % nrn) * 4 + (t & 3);
}

__device__ void phase_gemm_in(const Params& p, int layer, int bid, int nb, char* smem) {
  const int j = layer >> 1;
  if ((layer & 1) == 0) {
    EpiEvenIn epi{p, j};
    const u16* W = (const u16*)(p.ws + OFF_WEVIN) + (size_t)j * EV_IN * 2048;
    constexpr int NT = EV_IN / 128;
    const PlainA al{ws_H(p), 2048};
    for (int item = bid; item < 72 * NT; item += nb) {
      int mt, nt;
      tile_remap(item, nb, 72 * NT, NT, mt, nt);
      gemm_tile(al, mt * 128, W, 2048, nt * 128, 2048, mt * 128, nt * 128, smem, epi);
    }
  } else {
    EpiOddIn epi{p};
    const u16* W = (const u16*)(p.ws + OFF_WODIN) + (size_t)j * OD_IN * 2048;
    constexpr int NT = OD_IN / 128;
    const PlainA al{ws_H(p), 2048};
    for (int item = bid; item < 72 * NT; item += nb) {
      int mt, nt;
      tile_remap(item, nb, 72 * NT, NT, mt, nt);
      gemm_tile(al, mt * 128, W, 2048, nt * 128, 2048, mt * 128, nt * 128, smem, epi);
    }
  }
}

__device__ void phase_gemm_out(const Params& p, int layer, int bid, int nb, char* smem) {
  const int j = layer >> 1;
  EpiOut epi{p, layer};
  const u16* W = (const u16*)(p.ws + ((layer & 1) ? OFF_WODOUT : OFF_WEVOUT)) + (size_t)j * 2048 * 2048;
  const PlainA al{ws_MIX(p), 2048};
  const int nmt = (layer == 3) ? 64 : 72;
  for (int item = bid; item < nmt * 16; item += nb) {
    int mt, nt;
    tile_remap(item, nb, nmt * 16, 16, mt, nt);
    if (layer == 3) mt = (mt >> 4) * 18 + 2 + (mt & 15);
    gemm_tile(al, mt * 128, W, 2048, nt * 128, 2048, mt * 128, nt * 128, smem, epi);
  }
}

#define MFMA32(a, b, c) __builtin_amdgcn_mfma_f32_32x32x16_bf16((a), (b), (c), 0, 0, 0)

DI void attn_flash_item(const Params& p, int b, int h, int qb, char* smem) {
  const int tid = opaque_tid(), lane = tid & 63, wave = tid >> 6, l31 = lane & 31, hh = lane >> 5;
  const int kvh = h / 3;
  const int ntiles = (qb < 2) ? 4 : 36;
  u16* Ks = (u16*)smem;
  u16* Vs = Ks + 64 * 136;
  const u16* Kg = ws_KB(p) + (size_t)(b * 4 + kvh) * 2304 * 128;
  const u16* Vg = ws_VT(p) + (size_t)(b * 4 + kvh) * 128 * 2304;
  const int r = b * SPB + qb * 128 + wave * 32 + l31;
  bf16x8 qf[8];
  {
    const u16* qp = ws_P(p) + (size_t)r * EV_IN + EQ + h * 128 + hh * 8;
#pragma unroll
    for (int s = 0; s < 8; ++s) qf[s] = *(const bf16x8*)(qp + s * 16);
  }
  f32x16 ot[4];
#pragma unroll
  for (int db = 0; db < 4; ++db)
#pragma unroll
    for (int i = 0; i < 16; ++i) ot[db][i] = 0.f;
  float m = -1e30f, l = 0.f;
  const int kkey = tid >> 4, kch = (tid & 15) * 8;
  const int vd = tid >> 3, vch = (tid & 7) * 8;
  u32x4 kr[4], vr[4];
#pragma unroll
  for (int i = 0; i < 4; ++i) {
    kr[i] = *(const u32x4*)(Kg + (size_t)(kkey + 16 * i) * 128 + kch);
    vr[i] = *(const u32x4*)(Vg + (size_t)(vd + 32 * i) * 2304 + vch);
  }
  for (int t = 0; t < ntiles; ++t) {
    __syncthreads();
#pragma unroll
    for (int i = 0; i < 4; ++i) {
      *(u32x4*)(Ks + (kkey + 16 * i) * 136 + kch) = kr[i];
      u32x2 lo, hi;
      lo[0] = vr[i][0]; lo[1] = vr[i][1]; hi[0] = vr[i][2]; hi[1] = vr[i][3];
      *(u32x2*)(Vs + (vd + 32 * i) * 68 + vch) = lo;
      *(u32x2*)(Vs + (vd + 32 * i) * 68 + vch + 4) = hi;
    }
    __syncthreads();
    if (t + 1 < ntiles) {
#pragma unroll
      for (int i = 0; i < 4; ++i) {
        kr[i] = *(const u32x4*)(Kg + (size_t)((t + 1) * 64 + kkey + 16 * i) * 128 + kch);
        vr[i] = *(const u32x4*)(Vg + (size_t)(vd + 32 * i) * 2304 + (t + 1) * 64 + vch);
      }
    }
    f32x16 st[2];
#pragma unroll
    for (int kb = 0; kb < 2; ++kb) {
#pragma unroll
      for (int i = 0; i < 16; ++i) st[kb][i] = 0.f;
#pragma unroll
      for (int s = 0; s < 8; ++s) {
        bf16x8 ka = *(const bf16x8*)(Ks + (kb * 32 + l31) * 136 + s * 16 + hh * 8);
        st[kb] = MFMA32(ka, qf[s], st[kb]);
      }
    }
    float mx = st[0][0];
#pragma unroll
    for (int i = 1; i < 16; ++i) mx = fmaxf(mx, st[0][i]);
#pragma unroll
    for (int i = 0; i < 16; ++i) mx = fmaxf(mx, st[1][i]);
    {
      const auto rr = __builtin_amdgcn_permlane32_swap(__float_as_uint(mx), __float_as_uint(mx), false, false);
      mx = fmaxf(__uint_as_float(rr[0]), __uint_as_float(rr[1]));
    }
    constexpr float THR2 = 8.f * 1.4426950408889634f;
    if (__builtin_amdgcn_ballot_w64(mx - m > THR2) != 0ull) {
      const float mnew = fmaxf(m, mx);
      const float alpha = __builtin_amdgcn_exp2f(m - mnew);
      l *= alpha;
#pragma unroll
      for (int db = 0; db < 4; ++db)
#pragma unroll
        for (int i = 0; i < 16; ++i) ot[db][i] *= alpha;
      m = mnew;
    }
    float ls = 0.f;
#pragma unroll
    for (int kb = 0; kb < 2; ++kb)
#pragma unroll
      for (int i = 0; i < 16; ++i) {
        const float pv = __builtin_amdgcn_exp2f(st[kb][i] - m);
        st[kb][i] = pv;
        ls += pv;
      }
    l += ls;
#pragma unroll
    for (int kb = 0; kb < 2; ++kb)
#pragma unroll
      for (int s = 0; s < 2; ++s) {
        u32x4 pq;
        asm volatile(
            "v_cvt_pk_bf16_f32 %0, %4, %5\n\tv_cvt_pk_bf16_f32 %1, %6, %7\n\tv_cvt_pk_bf16_f32 %2, %8, %9\n\tv_cvt_pk_bf16_f32 %3, "
            "%10, %11\n\ts_nop 1"
            : "=&v"(pq[0]), "=&v"(pq[1]), "=&v"(pq[2]), "=&v"(pq[3])
            : "v"(st[kb][8 * s]), "v"(st[kb][8 * s + 1]), "v"(st[kb][8 * s + 2]), "v"(st[kb][8 * s + 3]),
              "v"(st[kb][8 * s + 4]), "v"(st[kb][8 * s + 5]), "v"(st[kb][8 * s + 6]), "v"(st[kb][8 * s + 7]));
        const bf16x8 pb = __builtin_bit_cast(bf16x8, pq);
#pragma unroll
        for (int db = 0; db < 4; ++db) {
          const u16* vp = Vs + (db * 32 + l31) * 68 + kb * 32 + s * 16 + hh * 4;
          const u32x2 a0 = *(const u32x2*)vp, a1 = *(const u32x2*)(vp + 8);
          u32x4 aq;
          aq[0] = a0[0]; aq[1] = a0[1]; aq[2] = a1[0]; aq[3] = a1[1];
          ot[db] = MFMA32(__builtin_bit_cast(bf16x8, aq), pb, ot[db]);
        }
      }
  }
  l += __shfl_xor(l, 32);
  const float linv = 1.f / l;
  const u16* gap = ws_P(p) + (size_t)r * EV_IN + EGA + h * 128;
  u16* op = ws_MIX(p) + (size_t)r * 2048 + h * 128;
#pragma unroll
  for (int db = 0; db < 4; ++db)
#pragma unroll
    for (int i4 = 0; i4 < 4; ++i4) {
      const int d0 = db * 32 + 8 * i4 + 4 * hh;
      const u32x2 g = *(const u32x2*)(gap + d0);
      u32x2 o;
      o[0] = pk(ot[db][4 * i4] * linv * blo(g[0]), ot[db][4 * i4 + 1] * linv * bhi(g[0]));
      o[1] = pk(ot[db][4 * i4 + 2] * linv * blo(g[1]), ot[db][4 * i4 + 3] * linv * bhi(g[1]));
      *(u32x2*)(op + d0) = o;
    }
}

__device__ void phase_even_mix(const Params& p, int layer, int bid, int nb, char* smem) {
  const int j = layer >> 1;
  constexpr int N_ATT = 864;
  constexpr int N_SGU = 288;
  EpiSgu epi{p, j};
  const int nfull = 768 / nb * nb;
  const int nlow = (768 - nfull < nb) ? 768 - nfull : nb;
  const int nhi = nb - nlow;
  const bool split = nhi > 0 && nlow > 0;
  for (int k = 0;; ++k) {
    int item;
    if (!split) {
      item = bid + k * nb;
    } else {
      const int hk = bid + k * nb;
      if (hk < 768) item = hk;
      else {
        if (bid < nlow) break;
        const int kh = (768 - bid + nb - 1) / nb;
        item = 768 + (bid - nlow) + (k - kh) * nhi;
      }
    }
    if (item >= N_ATT + N_SGU) break;
    if (item < N_ATT) {
      int qb, bh;
      if (item < 768) {
        qb = 2 + (item & 15);
        bh = item >> 4;
      } else {
        qb = (item - 768) & 1;
        bh = (item - 768) >> 1;
      }
      attn_flash_item(p, bh / 12, bh % 12, qb, smem);
    } else {
      const int it = item - N_ATT, chunk = it >> 2, g = it & 3;
      const PlainA al{(const u16*)(p.ws + OFF_WSB) + (size_t)(j * 4 + g) * 128 * 128, 128};
      const u16* Bt = (const u16*)(p.ws + OFF_BVT) + (size_t)(chunk * 4 + g) * 128 * 128;
      gemm_tile(al, 0, Bt, 128, 0, 128, chunk * 128, g * 128, smem, epi);
    }
  }
}

#define MFMA16(a, b, c) __builtin_amdgcn_mfma_f32_16x16x32_bf16((a), (b), (c), 0, 0, 0)
#define LDS_FENCE() asm volatile("s_waitcnt lgkmcnt(0)" ::: "memory")
constexpr int S5_DT = 20;
constexpr int S5_WAVE_LDS = 128 * S5_DT * 4;

struct S5W {
  float ar, ai;
  bf16x8 bb[8];
};

DI void s5_wave_setup(const Params& p, int jl, int dir, int g, int lane, S5W& w) {
  const size_t gi = (size_t)(jl * 2 + dir) * 64 + g;
  const float lre = p.s5_lam_re[gi * 64 + lane], lim = p.s5_lam_im[gi * 64 + lane];
  const float dt = expf(p.s5_log_dt[gi]);
  const float mag = expf(lre * dt);
  const float ang = lim * dt;
  w.ar = mag * cosf(ang);
  w.ai = mag * sinf(ang);
  const float xr = w.ar - 1.f, xi = w.ai;
  const float den = lre * lre + lim * lim;
  const float cr = (xr * lre + xi * lim) / den, ci = (xi * lre - xr * lim) / den;
  const int col = lane & 15, quad = lane >> 4;
#pragma unroll
  for (int nt = 0; nt < 8; ++nt) {
    const int nidx = nt * 16 + col, n = nidx & 63;
    const float crn = __shfl(cr, n), cin = __shfl(ci, n);
    u32x4 q;
    q[0] = 0u; q[1] = 0u; q[2] = 0u; q[3] = 0u;
    if (quad < 2) {
      const float* br = p.s5_b_re + (gi * 64 + n) * 16 + quad * 8;
      const float* bi = p.s5_b_im + (gi * 64 + n) * 16 + quad * 8;
      const f32x4 r0 = *(const f32x4*)br, r1 = *(const f32x4*)(br + 4), i0 = *(const f32x4*)bi, i1 = *(const f32x4*)(bi + 4);
      float v[8];
#pragma unroll
      for (int e = 0; e < 4; ++e) {
        v[e] = (nt < 4) ? (crn * r0[e] - cin * i0[e]) : (crn * i0[e] + cin * r0[e]);
        v[4 + e] = (nt < 4) ? (crn * r1[e] - cin * i1[e]) : (crn * i1[e] + cin * r1[e]);
      }
      q = pack8(v);
    }
    w.bb[nt] = __builtin_bit_cast(bf16x8, q);
  }
}

DI void s5_readout_frags(const Params& p, int jl, int dir, int g, int lane, bf16x8* cm) {
  const size_t gi = (size_t)(jl * 2 + dir) * 64 + g;
  const int col = lane & 15, quad = lane >> 4;
#pragma unroll
  for (int ks = 0; ks < 4; ++ks) {
    const int n0 = ks * 16 + quad * 4;
    const f32x4 cr = *(const f32x4*)(p.s5_c_re + (gi * 16 + col) * 64 + n0);
    const f32x4 ci = *(const f32x4*)(p.s5_c_im + (gi * 16 + col) * 64 + n0);
    float v[8];
#pragma unroll
    for (int e = 0; e < 4; ++e) {
      v[2 * e] = cr[e];
      v[2 * e + 1] = -ci[e];
    }
    cm[ks] = __builtin_bit_cast(bf16x8, pack8(v));
  }
}

DI void s5_table_store(const Params& p, int jl, int dir, int g, int lane) {
  S5W w;
  bf16x8 cm[4];
  s5_wave_setup(p, jl, dir, g, lane, w);
  s5_readout_frags(p, jl, dir, g, lane, cm);
  u32* T = (u32*)(p.ws + OFF_S5T) + (size_t)((jl * 2 + dir) * 64 + g) * S5T_WORDS;
  T[lane] = __float_as_uint(w.ar);
  T[64 + lane] = __float_as_uint(w.ai);
#pragma unroll
  for (int nt = 0; nt < 8; ++nt) *(u32x4*)(T + 128 + (nt * 64 + lane) * 4) = __builtin_bit_cast(u32x4, w.bb[nt]);
#pragma unroll
  for (int ks = 0; ks < 4; ++ks) *(u32x4*)(T + 128 + 2048 + (ks * 64 + lane) * 4) = __builtin_bit_cast(u32x4, cm[ks]);
}
DI void s5_table_load(const Params& p, int jl, int dir, int g, int lane, S5W& w) {
  const u32* T = (const u32*)(p.ws + OFF_S5T) + (size_t)((jl * 2 + dir) * 64 + g) * S5T_WORDS;
  w.ar = __uint_as_float(T[lane]);
  w.ai = __uint_as_float(T[64 + lane]);
#pragma unroll
  for (int nt = 0; nt < 8; ++nt) w.bb[nt] = __builtin_bit_cast(bf16x8, *(const u32x4*)(T + 128 + (nt * 64 + lane) * 4));
}
DI void s5_table_load_cm(const Params& p, int jl, int dir, int g, int lane, bf16x8* cm) {
  const u32* T = (const u32*)(p.ws + OFF_S5T) + (size_t)((jl * 2 + dir) * 64 + g) * S5T_WORDS;
#pragma unroll
  for (int ks = 0; ks < 4; ++ks) cm[ks] = __builtin_bit_cast(bf16x8, *(const u32x4*)(T + 128 + 2048 + (ks * 64 + lane) * 4));
}

template <bool READ, int DIR>
DI void s5_run(const S5W& w, const bf16x8* cm, const u16* ug, float* Dt, float& hr, float& hi, f32x4* yacc, int lane) {
  const int col = lane & 15, quad = lane >> 4;
  u32x4 uq;
  uq[0] = 0u; uq[1] = 0u; uq[2] = 0u; uq[3] = 0u;
  if (quad < 2) uq = *(const u32x4*)(ug + (size_t)((DIR ? 7 : 0) * 16) * OD_IN);
#pragma unroll
  for (int bi = 0; bi < 8; ++bi) {
    const int bk = DIR ? 7 - bi : bi;
    const bf16x8 ua = __builtin_bit_cast(bf16x8, uq);
    if (bi < 7 && quad < 2) uq = *(const u32x4*)(ug + (size_t)((DIR ? bk - 1 : bk + 1) * 16) * OD_IN);
#pragma unroll
    for (int nt = 0; nt < 8; ++nt) {
      const f32x4 d = MFMA16(ua, w.bb[nt], (f32x4{0.f, 0.f, 0.f, 0.f}));
      *(f32x4*)(Dt + (nt * 16 + col) * S5_DT + quad * 4) = d;
    }
    LDS_FENCE();
#pragma unroll 1
    for (int s4 = 0; s4 < 4; ++s4) {
      const int tb = (DIR ? 3 - s4 : s4) * 4;
      const f32x4 dr = *(const f32x4*)(Dt + lane * S5_DT + tb);
      const f32x4 di = *(const f32x4*)(Dt + (64 + lane) * S5_DT + tb);
      u32x4 hp;
#pragma unroll
      for (int e = 0; e < 4; ++e) {
        const int ix = DIR ? 3 - e : e;
        const float nr = w.ar * hr - w.ai * hi + dr[ix], ni = w.ar * hi + w.ai * hr + di[ix];
        hr = nr;
        hi = ni;
        if (READ) hp[ix] = pk(hr, hi);
      }
      if (READ) *(u32x4*)(Dt + lane * S5_DT + tb) = hp;
    }
    if (READ) {
      LDS_FENCE();
      const u32* Hw = (const u32*)Dt;
#pragma unroll
      for (int ks = 0; ks < 4; ++ks) {
        u32x4 hq;
#pragma unroll
        for (int jj = 0; jj < 4; ++jj) hq[jj] = Hw[(ks * 16 + quad * 4 + jj) * S5_DT + col];
        yacc[bk] = MFMA16(__builtin_bit_cast(bf16x8, hq), cm[ks], yacc[bk]);
      }
    }
    LDS_FENCE();
  }
}

__device__ void phase_odd3(const Params& p, int layer, int bid, int nb, char* smem) {
  const int jl = layer >> 1;
  const int tid = opaque_tid(), lane = tid & 63, wave = tid >> 6;
  constexpr int N_CONV = 4608;
  constexpr int N_S5A = 2304;
  for (int item = bid; item < N_CONV + N_S5A; item += nb) {
    if (item < N_S5A) {
      const int w = item * 4 + wave;
      const int seg = w % 18, dir = (w / 18) & 1, g = (w / 36) & 63, b = w / (36 * 64);
      float* D = (float*)(smem + wave * S5_WAVE_LDS);
      const u16* ug = ws_P(p) + (size_t)(b * SPB + seg * 128 + (lane & 15)) * OD_IN + g * 16 + (lane >> 4) * 8;
      S5W q;
      s5_table_load(p, jl, dir, g, lane, q);
      float hr = 0.f, hi = 0.f;
      if (dir) s5_run<false, 1>(q, nullptr, ug, D, hr, hi, nullptr, lane);
      else s5_run<false, 0>(q, nullptr, ug, D, hr, hi, nullptr, lane);
      float* E = ws_E(p) + ((((size_t)dir * 4 + b) * 64 + g) * 18 + seg) * 128;
      E[lane * 2] = hr;
      E[lane * 2 + 1] = hi;
    } else {
      const int id = (item - N_S5A) * 256 + tid;
      const int r = id >> 7, ch = (id & 127) * 8;
      const ConvA ca{p, jl, ch >> 7};
      float a8[8];
      ca.conv8(r, ch, a8);
      *(u32x4*)((u16*)(p.ws + OFF_XC) + (size_t)r * 1024 + ch) = pack8(a8);
    }
  }
}

__device__ __forceinline__ void phase_odd3b(const Params& p, int layer, int bid, int nb, char* smem) {
  const int jl = layer >> 1;
  constexpr int N_LRU = 72 * 8 * 4;
  for (int item = bid; item < N_LRU; item += nb) {
    const int ntile = item & 3, h = (item >> 2) & 7, mt = item >> 5;
    const PlainA al{(const u16*)(p.ws + OFF_XC) + h * 128, 1024};
    EpiLru epi{p, jl, h};
    const u16* Bt = (const u16*)(p.ws + OFF_WLRU) + (size_t)(jl * 8 + h) * 512 * 128;
    gemm_tile(al, mt * 128, Bt, 128, ntile * 128, 128, mt * 128, ntile * 128, smem, epi);
  }
}

DI int s5_order_seg(int dir, int pos) { return dir ? (pos < 2 ? 1 - pos : 19 - pos) : pos; }
DI int s5_order_pos(int dir, int seg) { return dir ? (seg < 2 ? 1 - seg : 19 - seg) : seg; }

DI void s5_init_state(const Params& p, const S5W& q, int dir, int b, int g, int seg, int lane, float& hr, float& hi) {
  float pr = q.ar, pi_ = q.ai;
#pragma unroll
  for (int k = 0; k < 7; ++k) {
    const float nr = pr * pr - pi_ * pi_, ni = 2.f * pr * pi_;
    pr = nr;
    pi_ = ni;
  }
  hr = 0.f;
  hi = 0.f;
  const int mypos = s5_order_pos(dir, seg);
  const float* E = ws_E(p) + (((size_t)dir * 4 + b) * 64 + g) * 18 * 128;
  float er[17], ei[17];
#pragma unroll
  for (int pos = 0; pos < 17; ++pos) {
    const int sg = s5_order_seg(dir, pos);
    const float2 ev = *(const float2*)(E + sg * 128 + lane * 2);
    er[pos] = ev.x;
    ei[pos] = ev.y;
  }
#pragma unroll
  for (int pos = 0; pos < 17; ++pos) {
    if (pos < mypos) {
      const float nr = pr * hr - pi_ * hi + er[pos], ni = pr * hi + pi_ * hr + ei[pos];
      hr = nr;
      hi = ni;
    }
  }
}

constexpr int LRU_FIN_PER = 4;
DI unsigned xb_ld(unsigned* p);
DI unsigned xb_add(unsigned* p, unsigned v);
DI void lru_final_item(const Params& p, int it, int tid) {
  const u16* P = ws_P(p);
  const int bc = it >> 2, ch = (it & 3) * 256 + tid;
  const int b = bc / 144, c = bc % 144;
  const int r0 = bc * 16;
  const size_t ci = ((size_t)b * 144 + c) * 1024 + ch;
  const float* LA0 = ws_LA(p) + (size_t)r0 * 1024 + ch;
  const float* LB0 = ws_LB(p) + (size_t)r0 * 1024 + ch;
  const float* LA1 = LA0 + (size_t)ROWS * 1024;
  const float* LB1 = LB0 + (size_t)ROWS * 1024;
  float hf[16];
  float h = ws_CIN(p)[ci];
#pragma unroll
  for (int t = 0; t < 16; ++t) {
    h = __builtin_nontemporal_load(LA0 + (size_t)t * 1024) * h + __builtin_nontemporal_load(LB0 + (size_t)t * 1024);
    hf[t] = h;
  }
  h = ws_CIN(p)[(size_t)4 * 144 * 1024 + ci];
#pragma unroll
  for (int tt = 0; tt < 16; ++tt) {
    const int t = 15 - tt;
    h = __builtin_nontemporal_load(LA1 + (size_t)t * 1024) * h + __builtin_nontemporal_load(LB1 + (size_t)t * 1024);
    const float gd = bf2f(P[(size_t)(r0 + t) * OD_IN + OGD + ch]);
    ws_MIX(p)[(size_t)(r0 + t) * 2048 + 1024 + ch] = f2bf((hf[t] + h) * gd);
  }
}

__device__ void phase_odd4(const Params& p, int layer, int bid, int nb, char* smem) {
  const int jl = layer >> 1;
  const int tid = opaque_tid(), lane = tid & 63, wave = tid >> 6;
  constexpr int N_CAR = 32;
  constexpr int N_S5B = 1152;
  constexpr int N_FIN = 2304;
  unsigned* carry_done = (unsigned*)(p.ws + OFF_BAR) + 64 + jl;
  for (int item = bid; item < N_CAR + N_S5B; item += nb) {
    if (item < N_CAR) {
      const int id = item * 256 + tid;
      const int ch = id & 1023, b = (id >> 10) & 3, dir = id >> 12;
      const float* SA = ws_SA(p) + ((size_t)dir * 4 + b) * 144 * 1024 + ch;
      const float* SBp = ws_SB(p) + ((size_t)dir * 4 + b) * 144 * 1024 + ch;
      float* CI = ws_CIN(p) + ((size_t)dir * 4 + b) * 144 * 1024 + ch;
      float h = 0.f;
#pragma unroll 8
      for (int k = 0; k < 144; ++k) {
        const int c = dir ? (k < 16 ? 15 - k : 159 - k) : k;
        CI[(size_t)c * 1024] = h;
        h = SA[(size_t)c * 1024] * h + SBp[(size_t)c * 1024];
      }
      asm volatile("s_waitcnt vmcnt(0)" ::: "memory");
      __syncthreads();
      if (tid == 0) {
        __builtin_amdgcn_fence(__ATOMIC_RELEASE, "agent");
        asm volatile("s_waitcnt vmcnt(0)" ::: "memory");
        (void)xb_add(carry_done, 1u);
      }
    } else {
      const int w = (item - N_CAR) * 4 + wave;
      const int seg = w % 18, g = (w / 18) & 63, b = w / (18 * 64);
      float* D = (float*)(smem + wave * S5_WAVE_LDS);
      const size_t row0 = (size_t)(b * SPB + seg * 128);
      const u16* ug = ws_P(p) + (row0 + (lane & 15)) * OD_IN + g * 16 + (lane >> 4) * 8;
      f32x4 yacc[8];
#pragma unroll
      for (int k = 0; k < 8; ++k) yacc[k] = f32x4{0.f, 0.f, 0.f, 0.f};
      {
        S5W q;
        bf16x8 cm[4];
        s5_table_load(p, jl, 0, g, lane, q);
        s5_table_load_cm(p, jl, 0, g, lane, cm);
        float hr, hi;
        s5_init_state(p, q, 0, b, g, seg, lane, hr, hi);
        s5_run<true, 0>(q, cm, ug, D, hr, hi, yacc, lane);
      }
      {
        S5W q;
        bf16x8 cm[4];
        s5_table_load(p, jl, 1, g, lane, q);
        s5_table_load_cm(p, jl, 1, g, lane, cm);
        float hr, hi;
        s5_init_state(p, q, 1, b, g, seg, lane, hr, hi);
        s5_run<true, 1>(q, cm, ug, D, hr, hi, yacc, lane);
      }
      const int col = lane & 15, quad = lane >> 4;
#pragma unroll
      for (int bk = 0; bk < 8; ++bk)
#pragma unroll
        for (int j = 0; j < 4; ++j) D[(bk * 16 + quad * 4 + j) * 16 + col] = yacc[bk][j];
      LDS_FENCE();
      u16* YG = ws_YG(p);
      const u16* P = ws_P(p);
#pragma unroll
      for (int i = 0; i < 4; ++i) {
        const int id = lane + 64 * i, t = id >> 1, hf = id & 1;
        float u[8], y[8];
        unpack8(*(const u32x4*)(P + (row0 + t) * OD_IN + g * 16 + hf * 8), u);
        const f32x4 y0 = *(const f32x4*)(D + t * 16 + hf * 8), y1 = *(const f32x4*)(D + t * 16 + hf * 8 + 4);
        const float* dsk = p.s5_d + jl * 1024 + g * 16 + hf * 8;
#pragma unroll
        for (int e = 0; e < 8; ++e) {
          const float yy = ((e < 4) ? y0[e & 3] : y1[e & 3]) + dsk[e] * u[e];
          y[e] = 0.5f * yy * (1.f + tanhf(0.7978845608028654f * (yy + 0.044715f * yy * yy * yy)));
        }
        *(u32x4*)(YG + (row0 + t) * 1024 + g * 16 + hf * 8) = pack8(y);
      }
      LDS_FENCE();
    }
  }
  const int rem = (N_CAR + N_S5B) % nb;
  if (rem > 0 && bid >= rem) {
    const int nshort = nb - rem;
    if (tid == 0) {
      unsigned sp = 0;
      while (xb_ld(carry_done) < (unsigned)N_CAR && sp < (1u << 22)) {
        __builtin_amdgcn_s_sleep(2);
        ++sp;
      }
      __builtin_amdgcn_fence(__ATOMIC_ACQUIRE, "agent");
      asm volatile("s_waitcnt vmcnt(0)" ::: "memory");
    }
    __syncthreads();
    for (int j = 0; j < LRU_FIN_PER; ++j) {
      const int it = (bid - rem) + j * nshort;
      if (it < N_FIN) lru_final_item(p, it, tid);
    }
  }
}

__device__ void phase_odd5(const Params& p, int layer, int bid, int nb, char* smem) {
  const int jl = layer >> 1;
  constexpr int N_GLU = 72 * 8;
  EpiGlu epi{p, jl};
  const u16* W = (const u16*)(p.ws + OFF_WGLU) + (size_t)jl * 1024 * 1024;
  const PlainA al{ws_YG(p), 1024};
  const int tid = opaque_tid();
  const int rem = (32 + 1152) % nb;
  int n4 = (rem > 0) ? LRU_FIN_PER * (nb - rem) : 0;
  if (n4 > 2304) n4 = 2304;
  for (int item = bid; item < N_GLU + (2304 - n4); item += nb) {
    if (item < N_GLU) {
      int mt, nt;
      tile_remap(item, nb, N_GLU, 8, mt, nt);
      gemm_tile(al, mt * 128, W, 1024, nt * 128, 1024, mt * 128, nt * 128, smem, epi);
    } else {
      lru_final_item(p, n4 + item - N_GLU, tid);
    }
  }
}

#define XB_TMO 128
#define XB_XCNT(j) (256 + 64 * (j))
#define XB_XSUB(j) (1280 + 64 * (j))
#define XB_XGEN(j) (2304 + 64 * (j))
#define XB_TOP 3328
#define XB_TOPGEN 3392
#define XB_SPIN_CAP (1u << 20)
#define LAS __attribute__((address_space(3)))
DI unsigned xb_ld(unsigned* p) { return __hip_atomic_load(p, __ATOMIC_RELAXED, __HIP_MEMORY_SCOPE_AGENT); }
DI unsigned xb_add(unsigned* p, unsigned v) { return __hip_atomic_fetch_add(p, v, __ATOMIC_RELAXED, __HIP_MEMORY_SCOPE_AGENT); }
DI unsigned xb_xcc_id() { return (unsigned)__builtin_amdgcn_s_getreg((3 << 11) | 20) & 0xFu; }
#define XB_SPIN(cond, bar)                                         \
  do {                                                             \
    unsigned _sp = 0;                                              \
    while (cond) {                                                 \
      __builtin_amdgcn_s_sleep(1);                                 \
      if ((++_sp & 255u) == 0u) {                                  \
        if (xb_ld(&(bar)[XB_TMO])) break;                          \
        if (_sp > XB_SPIN_CAP) {                                   \
          atomicAdd(&(bar)[XB_TMO], 1u);                           \
          break;                                                   \
        }                                                          \
      }                                                            \
    }                                                              \
  } while (0)
struct XcdBarrier {
  unsigned* bar;
  unsigned x;
  volatile LAS unsigned* st;
};
DI XcdBarrier xcd_barrier_post(unsigned* bar, volatile LAS unsigned* st) {
  XcdBarrier b;
  b.bar = bar;
  b.x = xb_xcc_id();
  b.st = st;
  if (threadIdx.x == 0) (void)xb_add(&bar[XB_XCNT(b.x)], 1u);
  return b;
}
DI void xcd_barrier_complete(unsigned* bar, unsigned x, unsigned& nloc, unsigned& nx) {
  const unsigned G = gridDim.x * gridDim.y * gridDim.z;
  unsigned sum, cnt, mine, sp = 0u;
  for (;;) {
    sum = 0u;
    cnt = 0u;
    mine = 0u;
#pragma unroll
    for (unsigned j = 0; j < 16; ++j) {
      const unsigned c = xb_ld(&bar[XB_XCNT(j)]);
      sum += c;
      cnt += (c > 0u) ? 1u : 0u;
      mine = (j == x) ? c : mine;
    }
    if (sum == G) break;
    __builtin_amdgcn_s_sleep(1);
    if ((++sp & 255u) == 0u) {
      if (xb_ld(&bar[XB_TMO])) break;
      if (sp > XB_SPIN_CAP) {
        atomicAdd(&bar[XB_TMO], 1u);
        break;
      }
    }
  }
  nloc = mine > 0u ? mine : 1u;
  nx = cnt > 0u ? cnt : 1u;
}
DI void xcd_barrier(const XcdBarrier& b) {
  asm volatile("s_waitcnt vmcnt(0)" ::: "memory");
  __syncthreads();
  if (threadIdx.x == 0) {
    unsigned* bar = b.bar;
    __builtin_amdgcn_s_waitcnt(0);
    unsigned nloc = b.st[0], nx = b.st[1];
    if (nloc == 0u) {
      xcd_barrier_complete(bar, b.x, nloc, nx);
      b.st[0] = nloc;
      b.st[1] = nx;
    }
    const unsigned old = xb_add(&bar[XB_XSUB(b.x)], 1u);
    const unsigned gen = old / nloc;
    if (old + 1u == (gen + 1u) * nloc) {
      __builtin_amdgcn_fence(__ATOMIC_RELEASE, "agent");
      asm volatile("s_waitcnt vmcnt(0)" ::: "memory");
      const unsigned og = xb_add(&bar[XB_TOP], 1u);
      const unsigned tg = og / nx;
      if (og + 1u == (tg + 1u) * nx) xb_add(&bar[XB_TOPGEN], 1u);
      else XB_SPIN(xb_ld(&bar[XB_TOPGEN]) == tg, bar);
      __builtin_amdgcn_fence(__ATOMIC_ACQUIRE, "agent");
      xb_add(&bar[XB_XGEN(b.x)], 1u);
      asm volatile("s_waitcnt vmcnt(0)" ::: "memory");
    } else {
      XB_SPIN(xb_ld(&bar[XB_XGEN(b.x)]) == gen, bar);
      __builtin_amdgcn_fence(__ATOMIC_ACQUIRE, "agent");
      asm volatile("s_waitcnt vmcnt(0)" ::: "memory");
    }
  }
  __syncthreads();
}

__device__ void run_phase(const Params& p, int ph, int bid, int nb, char* smem) {
  if (ph == 0) {
    phase_prep(p, bid, nb, smem);
    return;
  }
  int layer, sub;
  if (ph <= 4) { layer = 0; sub = ph - 1; }
  else if (ph <= 11) { layer = 1; sub = ph - 5; }
  else if (ph <= 15) { layer = 2; sub = ph - 12; }
  else { layer = 3; sub = ph - 16; }
  if ((layer & 1) == 0) {
    if (sub == 0) phase_norm(p, layer, bid, nb);
    else if (sub == 1) phase_gemm_in(p, layer, bid, nb, smem);
    else if (sub == 2) phase_even_mix(p, layer, bid, nb, smem);
    else phase_gemm_out(p, layer, bid, nb, smem);
  } else {
    if (sub == 0) phase_norm(p, layer, bid, nb);
    else if (sub == 1) phase_gemm_in(p, layer, bid, nb, smem);
    else if (sub == 2) phase_odd3(p, layer, bid, nb, smem);
    else if (sub == 3) phase_odd3b(p, layer, bid, nb, smem);
    else if (sub == 4) phase_odd4(p, layer, bid, nb, smem);
    else if (sub == 5) phase_odd5(p, layer, bid, nb, smem);
    else phase_gemm_out(p, layer, bid, nb, smem);
  }
}

#if !MEGA
__global__ void __launch_bounds__(256, 2) k_phase(Params p, int ph) {
  __shared__ __attribute__((aligned(16))) char smem[SMEM_BYTES];
  run_phase(p, ph, blockIdx.x, gridDim.x, smem);
}
#else
__global__ void __launch_bounds__(256, 2) k_mega(Params p) {
  __shared__ __attribute__((aligned(16))) char smem[SMEM_BYTES];
  cg::grid_group grid = cg::this_grid();
#ifdef __HIP_DEVICE_COMPILE__
  __shared__ uint4 xb_words;
  if (threadIdx.x == 0) xb_words = make_uint4(0u, 0u, 0u, 0u);
  __syncthreads();
  if (p.ws == nullptr) grid.sync();
  const XcdBarrier xb = xcd_barrier_post((unsigned*)(p.ws + OFF_BAR), (volatile LAS unsigned*)&xb_words);
  typedef const Params __attribute__((address_space(4))) * CPP;
  int ph = 0;
#ifdef PROBE_PH
  int rep = 0;
#endif
  while (ph < NPHASE) {
    CPP q = (CPP)__builtin_amdgcn_kernarg_segment_ptr();
    asm volatile("" : "+s"(q));
    const Params lp = *q;
    run_phase(lp, ph, blockIdx.x, gridDim.x, smem);
#ifdef PROBE_PH
    if (ph == PROBE_PH && rep < PROBE_REP) {
      ++rep;
      --ph;
    }
#endif
    ++ph;
    if (ph < NPHASE) {
      xcd_barrier(xb);
    }
  }
#endif
}
#endif

extern "C" void kernel_launch(void* const* d_in, const int* in_sizes, int n_in, void* d_out, int out_size, void* d_ws,
                              size_t ws_size, hipStream_t stream) {
  Params p{};
  const float** pp = (const float**)&p;
  for (int i = 0; i < 33; ++i) pp[i] = (const float*)d_in[i];
  p.out = (float*)d_out;
  p.ws = (char*)d_ws;
  if (ws_size < WS_TOTAL) fprintf(stderr, "workspace too small: %zu < %zu\n", ws_size, (size_t)WS_TOTAL);
  (void)hipMemsetAsync((char*)d_ws + OFF_MODS, 0, OFF_BAR + SZ_BAR, stream);
#if MEGA
  static int grid_blocks = 0;
  if (!grid_blocks) {
    int dev = 0, cus = 0, per_cu = 0;
    hipGetDevice(&dev);
    hipDeviceGetAttribute(&cus, hipDeviceAttributeMultiprocessorCount, dev);
    hipOccupancyMaxActiveBlocksPerMultiprocessor(&per_cu, k_mega, 256, 0);
    if (per_cu > 2) per_cu = 2;
    grid_blocks = cus * per_cu;
  }
  void* args[] = {&p};
  hipError_t e = hipLaunchCooperativeKernel((void*)k_mega, dim3(grid_blocks), dim3(256), args, 0, stream);
  if (e != hipSuccess) fprintf(stderr, "cooperative launch failed: %s (grid %d)\n", hipGetErrorString(e), grid_blocks);
#else
  for (int ph = 0; ph < NPHASE; ++ph) k_phase<<<1024, 256, 0, stream>>>(p, ph);
#endif
}
```

```cpp
#include <hip/hip_runtime.h>
#include <hip/hip_cooperative_groups.h>
#include <cstdio>
namespace cg = cooperative_groups;

#ifndef MEGA
#define MEGA 1
#endif

typedef unsigned short u16;
typedef unsigned int u32;
using bf16x8 = __attribute__((ext_vector_type(8))) short;
using f32x4 = __attribute__((ext_vector_type(4))) float;
using u32x4 = __attribute__((ext_vector_type(4))) unsigned;
using u32x2 = __attribute__((ext_vector_type(2))) unsigned;
#define DI __device__ __forceinline__
__device__ __forceinline__ int opaque_tid() {
  int t = threadIdx.x;
  asm volatile("" : "+v"(t));
  return t;
}

constexpr int DM = 2048, SPB = 2304, ROWS = 9216;
constexpr int EV_IN = 5632, OD_IN = 4096;
constexpr float EPS = 1e-6f;
constexpr int EQ = 1024, EBU = 2560, EBV = 3072, EGA = 3584, EGB = 5120;
constexpr int OXD = 1024, OGC = 2048, OGD = 3072;
using f32x16 = __attribute__((ext_vector_type(16))) float;
constexpr float ATT_CS = 0.08838834764831845f * 1.4426950408889634f;
constexpr int SMEM_BYTES = 51200;
constexpr int NPHASE = 23;

constexpr size_t al(size_t x) { return (x + 255) & ~size_t(255); }
constexpr size_t OFF_MODS = 0;
constexpr size_t SZ_MODS = (size_t)4 * 5 * 6144 * 4;
constexpr size_t OFF_BAR = al(OFF_MODS + SZ_MODS);
constexpr size_t SZ_BAR = 3456 * 4;
constexpr size_t OFF_X = al(OFF_BAR + SZ_BAR);
constexpr size_t OFF_H = al(OFF_X + (size_t)ROWS * DM * 4);
constexpr size_t OFF_P = al(OFF_H + (size_t)ROWS * DM * 2);
constexpr size_t OFF_MIX = al(OFF_P + (size_t)ROWS * EV_IN * 2);
constexpr size_t OFF_KB = al(OFF_MIX + (size_t)ROWS * DM * 2);
constexpr size_t OFF_VT = al(OFF_KB + (size_t)16 * 2304 * 128 * 2);
constexpr size_t OFF_ROPE = al(OFF_VT + (size_t)16 * 2304 * 128 * 2);
constexpr size_t OFF_WEVIN = al(OFF_ROPE + (size_t)2 * 2048 * 64 * 4);
constexpr size_t OFF_WEVOUT = al(OFF_WEVIN + (size_t)2 * 5632 * 2048 * 2);
constexpr size_t OFF_WODIN = al(OFF_WEVOUT + (size_t)2 * 2048 * 2048 * 2);
constexpr size_t OFF_WODOUT = al(OFF_WODIN + (size_t)2 * 4096 * 2048 * 2);
constexpr size_t OFF_WGLU = al(OFF_WODOUT + (size_t)2 * 2048 * 2048 * 2);
constexpr size_t OFF_YG = al(OFF_WGLU + (size_t)2 * 1024 * 1024 * 2);
constexpr size_t OFF_E = al(OFF_YG + (size_t)ROWS * 1024 * 2);
constexpr size_t OFF_LA = al(OFF_E + (size_t)2 * 4 * 64 * 18 * 64 * 2 * 4);
constexpr size_t OFF_LB = al(OFF_LA + (size_t)2 * ROWS * 1024 * 4);
constexpr size_t OFF_SA = al(OFF_LB + (size_t)2 * ROWS * 1024 * 4);
constexpr size_t OFF_SB = al(OFF_SA + (size_t)2 * 4 * 144 * 1024 * 4);
constexpr size_t OFF_CIN = al(OFF_SB + (size_t)2 * 4 * 144 * 1024 * 4);
constexpr size_t OFF_BVT = al(OFF_CIN + (size_t)2 * 4 * 144 * 1024 * 4);
constexpr size_t OFF_WSB = al(OFF_BVT + (size_t)72 * 4 * 128 * 128 * 2);
constexpr size_t OFF_WLRU = al(OFF_WSB + (size_t)2 * 4 * 128 * 128 * 2);
constexpr size_t OFF_C8 = al(OFF_WLRU + (size_t)2 * 8 * 512 * 128 * 2);
constexpr size_t OFF_XC = al(OFF_C8 + (size_t)4096 * 4);
constexpr size_t OFF_S5T = al(OFF_XC + (size_t)ROWS * 1024 * 2);
constexpr int S5T_WORDS = 128 + 8 * 64 * 4 + 4 * 64 * 4;
constexpr size_t WS_TOTAL = al(OFF_S5T + (size_t)256 * S5T_WORDS * 4);

struct Params {
  const float *x, *c, *ctx, *c_ctx, *ada_w, *ada_b, *norm_g, *ev_w_in, *ev_w_out, *ev_q_g, *ev_k_g, *ev_sgu_g, *ev_ws,
      *ev_bs, *od_w_in, *od_w_out, *s5_lam_re, *s5_lam_im, *s5_log_dt, *s5_b_re, *s5_b_im, *s5_c_re, *s5_c_im, *s5_d,
      *s5_glu_w, *s5_glu_b, *lru_conv_w, *lru_conv_b, *lru_lam, *lru_wa, *lru_ba, *lru_wx, *lru_bx;
  float* out;
  char* ws;
};

DI u16 f2bf(float x) {
  u32 u = __float_as_uint(x);
  u += 0x7fffu + ((u >> 16) & 1u);
  return (u16)(u >> 16);
}
DI float bf2f(u16 v) { return __uint_as_float(((u32)v) << 16); }
DI float blo(u32 v) { return __uint_as_float(v << 16); }
DI float bhi(u32 v) { return __uint_as_float(v & 0xffff0000u); }
DI u32 pk(float a, float b) { return (u32)f2bf(a) | ((u32)f2bf(b) << 16); }
DI float sigmoidf_(float x) { return 1.f / (1.f + __expf(-x)); }
DI float siluf_(float x) { return x / (1.f + __expf(-x)); }
DI float red16(float v) {
  v += __shfl_xor(v, 1);
  v += __shfl_xor(v, 2);
  v += __shfl_xor(v, 4);
  v += __shfl_xor(v, 8);
  return v;
}
DI float wave_sum(float v) {
  v = red16(v);
  v += __shfl_xor(v, 16);
  v += __shfl_xor(v, 32);
  return v;
}
DI float wave_max(float v) {
#pragma unroll
  for (int o = 1; o < 64; o <<= 1) v = fmaxf(v, __shfl_xor(v, o));
  return v;
}
DI void unpack8(u32x4 q, float* v) {
#pragma unroll
  for (int e = 0; e < 4; ++e) {
    v[2 * e] = blo(q[e]);
    v[2 * e + 1] = bhi(q[e]);
  }
}
DI u32x4 pack8(const float* v) {
  u32x4 q;
#pragma unroll
  for (int e = 0; e < 4; ++e) q[e] = pk(v[2 * e], v[2 * e + 1]);
  return q;
}

DI float* ws_mods(const Params& p) { return (float*)(p.ws + OFF_MODS); }
DI float* ws_X(const Params& p) { return (float*)(p.ws + OFF_X); }
DI u16* ws_H(const Params& p) { return (u16*)(p.ws + OFF_H); }
DI u16* ws_P(const Params& p) { return (u16*)(p.ws + OFF_P); }
DI u16* ws_MIX(const Params& p) { return (u16*)(p.ws + OFF_MIX); }
DI u16* ws_KB(const Params& p) { return (u16*)(p.ws + OFF_KB); }
DI u16* ws_VT(const Params& p) { return (u16*)(p.ws + OFF_VT); }
DI float* ws_ROPE(const Params& p) { return (float*)(p.ws + OFF_ROPE); }
DI u16* ws_YG(const Params& p) { return (u16*)(p.ws + OFF_YG); }
DI float* ws_E(const Params& p) { return (float*)(p.ws + OFF_E); }
DI float* ws_LA(const Params& p) { return (float*)(p.ws + OFF_LA); }
DI float* ws_LB(const Params& p) { return (float*)(p.ws + OFF_LB); }
DI float* ws_SA(const Params& p) { return (float*)(p.ws + OFF_SA); }
DI float* ws_SB(const Params& p) { return (float*)(p.ws + OFF_SB); }
DI float* ws_CIN(const Params& p) { return (float*)(p.ws + OFF_CIN); }

DI void s5_table_store(const Params& p, int jl, int dir, int g, int lane);
__device__ void phase_prep(const Params& p, int bid, int nb, char* smem) {
  const int tid = opaque_tid();
  constexpr int N_ADA = 4 * 24 * 32;
  constexpr int T_EVIN = 2 * 32 * 88, T_EVOUT = 2 * 32 * 32, T_ODIN = 2 * 32 * 64, T_ODOUT = 2 * 32 * 32,
                T_GLU = 2 * 16 * 16, T_LRU = 2 * 32 * 4;
  constexpr int N_TR = T_EVIN + T_EVOUT + T_ODIN + T_ODOUT + T_GLU + T_LRU;
  constexpr int N_ROPE = 512;
  constexpr int N_WSB = 64;
  constexpr int N_C8 = 16;
  constexpr int N_S5T = 64;
  float* sf = (float*)smem;
  for (int item0 = bid; item0 < N_ADA + N_TR + N_ROPE + N_WSB + N_C8 + N_S5T; item0 += nb) {
    int item = item0;
    if (item0 < 5 * N_ADA) item = (item0 % 5 == 0) ? item0 / 5 : N_ADA + item0 - item0 / 5 - 1;
    if (item < N_ADA) {
      const int l = item / 768, rem = item % 768, cb = rem / 32, kc = rem % 32;
      const int n = cb * 256 + tid;
      if (tid < 64) {
#pragma unroll
        for (int i = 0; i < 5; ++i) {
          float cv = (i < 4) ? p.c[i * 2048 + kc * 64 + tid] : p.c_ctx[kc * 64 + tid];
          sf[i * 64 + tid] = cv / (1.f + expf(-cv));
        }
      }
      __syncthreads();
      float acc[5] = {0.f, 0.f, 0.f, 0.f, 0.f};
      const float* w = p.ada_w + ((size_t)l * 2048 + kc * 64) * 6144 + n;
#pragma unroll 8
      for (int k = 0; k < 64; ++k) {
        float wv = __builtin_nontemporal_load(w + (size_t)k * 6144);
#pragma unroll
        for (int i = 0; i < 5; ++i) acc[i] += sf[i * 64 + k] * wv;
      }
      float bias = (kc == 0) ? p.ada_b[l * 6144 + n] : 0.f;
      float* mods = ws_mods(p);
#pragma unroll
      for (int i = 0; i < 5; ++i) atomicAdd(&mods[(size_t)(l * 5 + i) * 6144 + n], acc[i] + bias);
      __syncthreads();
    } else if (item < N_ADA + N_TR) {
      int t = item - N_ADA;
      const float* src;
      u16* dst;
      int K, N;
      bool lru = false;
      int lru_type = 0;
      if (t < T_EVIN) {
        K = 2048; N = 5632; src = p.ev_w_in; dst = (u16*)(p.ws + OFF_WEVIN);
      } else if ((t -= T_EVIN) < T_EVOUT) {
        K = 2048; N = 2048; src = p.ev_w_out; dst = (u16*)(p.ws + OFF_WEVOUT);
      } else if ((t -= T_EVOUT) < T_ODIN) {
        K = 2048; N = 4096; src = p.od_w_in; dst = (u16*)(p.ws + OFF_WODIN);
      } else if ((t -= T_ODIN) < T_ODOUT) {
        K = 2048; N = 2048; src = p.od_w_out; dst = (u16*)(p.ws + OFF_WODOUT);
      } else if ((t -= T_ODOUT) < T_GLU) {
        K = 1024; N = 1024; src = p.s5_glu_w; dst = (u16*)(p.ws + OFF_WGLU);
      } else {
        t -= T_GLU;
        K = 128; N = 128;
        lru = true;
        src = (t < 128) ? p.lru_wa : p.lru_wx;
        dst = (u16*)(p.ws + OFF_WLRU);
        lru_type = (t < 128) ? 0 : 1;
        t &= 127;
      }
      const int ntn = N / 64, tpm = (K / 64) * ntn;
      const int mat = t / tpm, tt = t % tpm, kt = tt / ntn, nt = tt % ntn;
      src += (size_t)mat * K * N;
      if (!lru) dst += (size_t)mat * K * N;
      else {
        const int jl_ = mat >> 4, dir_ = (mat >> 3) & 1, h_ = mat & 7;
        dst += ((size_t)(jl_ * 8 + h_) * 512 + dir_ * 256 + 4 * lru_type) * 128;
      }
#pragma unroll
      for (int i = 0; i < 16; ++i) {
        int k = i * 4 + (tid >> 6), n = tid & 63;
        sf[k * 65 + n] = __builtin_nontemporal_load(src + (size_t)(kt * 64 + k) * N + nt * 64 + n);
      }
      __syncthreads();
      {
        const int n = tid >> 2, ks = (tid & 3) * 16;
        float v[16];
#pragma unroll
        for (int j = 0; j < 16; ++j) v[j] = sf[(ks + j) * 65 + n];
        const int nn = nt * 64 + n;
        const int drow = lru ? (8 * (nn >> 2) + (nn & 3)) : nn;
        u32x4* d = (u32x4*)(dst + (size_t)drow * K + kt * 64 + ks);
        d[0] = pack8(v);
        d[1] = pack8(v + 8);
      }
      __syncthreads();
    } else if (item >= N_ADA + N_TR + N_ROPE + N_WSB + N_C8) {
      const int e = (item - N_ADA - N_TR - N_ROPE - N_WSB - N_C8) * 4 + (tid >> 6);
      s5_table_store(p, e >> 7, (e >> 6) & 1, e & 63, tid & 63);
    } else if (item >= N_ADA + N_TR + N_ROPE + N_WSB) {
      const int idx = (item - N_ADA - N_TR - N_ROPE - N_WSB) * 256 + tid;
      ((float*)(p.ws + OFF_C8))[idx] = -8.f * log1pf(expf(-p.lru_lam[idx]));
    } else if (item >= N_ADA + N_TR + N_ROPE) {
      const int idx = ((item - N_ADA - N_TR - N_ROPE) * 256 + tid) * 8;
      float v[8];
      const f32x4 a0 = *(const f32x4*)(p.ev_ws + idx), a1 = *(const f32x4*)(p.ev_ws + idx + 4);
      v[0] = a0[0]; v[1] = a0[1]; v[2] = a0[2]; v[3] = a0[3];
      v[4] = a1[0]; v[5] = a1[1]; v[6] = a1[2]; v[7] = a1[3];
      *(u32x4*)((u16*)(p.ws + OFF_WSB) + idx) = pack8(v);
    } else {
      const int idx = (item - N_ADA - N_TR) * 256 + tid;
      const int i = idx & 63, tok = idx >> 6;
      const int row = tok >> 6, col = tok & 63, m = i & 31;
      const float pos = (float)((i < 32) ? row : col);
      const float inv = powf(10000.f, -(float)(2 * m) / 64.f);
      const float ang = pos * inv;
      float* rp = ws_ROPE(p);
      rp[idx] = cosf(ang);
      rp[2048 * 64 + idx] = sinf(ang);
    }
  }
}

__device__ void phase_norm(const Params& p, int layer, int bid, int nb) {
  const int lane = opaque_tid() & 63, wave = opaque_tid() >> 6;
  float* X = ws_X(p);
  u16* H = ws_H(p);
  const float* g = p.norm_g + layer * 2048;
  for (int item = bid; item < ROWS / 4; item += nb) {
    const int r = item * 4 + wave;
    const int b = r / SPB, s = r % SPB;
    const float* src;
    if (layer == 0)
      src = (s < 256) ? p.ctx + ((size_t)b * 256 + s) * 2048 : p.x + ((size_t)b * 2048 + (s - 256)) * 2048;
    else
      src = X + (size_t)r * 2048;
    const int mi = (s < 256) ? 4 : b;
    const float* md = ws_mods(p) + (size_t)(layer * 5 + mi) * 6144;
    f32x4 v[8];
    float ss = 0.f;
#pragma unroll
    for (int i = 0; i < 8; ++i) {
      v[i] = *(const f32x4*)(src + (i * 64 + lane) * 4);
      ss += v[i][0] * v[i][0] + v[i][1] * v[i][1] + v[i][2] * v[i][2] + v[i][3] * v[i][3];
    }
    ss = wave_sum(ss);
    const float rstd = rsqrtf(ss * (1.f / 2048.f) + EPS);
#pragma unroll
    for (int i = 0; i < 8; ++i) {
      const int c = (i * 64 + lane) * 4;
      f32x4 gv = *(const f32x4*)(g + c);
      f32x4 sh = *(const f32x4*)(md + c);
      f32x4 sc = *(const f32x4*)(md + 2048 + c);
      float h0 = v[i][0] * rstd * gv[0] * (1.f + sc[0]) + sh[0];
      float h1 = v[i][1] * rstd * gv[1] * (1.f + sc[1]) + sh[1];
      float h2 = v[i][2] * rstd * gv[2] * (1.f + sc[2]) + sh[2];
      float h3 = v[i][3] * rstd * gv[3] * (1.f + sc[3]) + sh[3];
      u32x2 o;
      o[0] = pk(h0, h1);
      o[1] = pk(h2, h3);
      *(u32x2*)(H + (size_t)r * 2048 + c) = o;
      if (layer == 0) *(f32x4*)(X + (size_t)r * 2048 + c) = v[i];
    }
  }
}

constexpr int LST = 64;

struct PlainA {
  static constexpr bool kDma = true;
  const u16* A;
  int lda;
  DI u32x4 load(int row, int k) const { return *(const u32x4*)(A + (size_t)row * lda + k); }
};

template <class AL, class Epi>
DI void gemm_tile(const AL& al, int arow0, const u16* __restrict__ Bt, int ldb, int brow0, int K, int m0, int n0,
                  char* smem, Epi& epi) {
  u16* sA = (u16*)smem;
  u16* sB = sA + 128 * LST;
  const int tid = opaque_tid(), lane = tid & 63, wave = tid >> 6, wm = wave >> 1, wn = wave & 1;
  const int fr = lane & 15, fq = lane >> 4;
  f32x4 acc[4][4];
#pragma unroll
  for (int i = 0; i < 4; ++i)
#pragma unroll
    for (int j = 0; j < 4; ++j) acc[i][j] = f32x4{0.f, 0.f, 0.f, 0.f};
  const int lrow = tid >> 3, lkc = (tid & 7) * 8;
  const int lkw = ((tid & 7) ^ (lrow & 7)) * 8;
  const u16* Bg = Bt + (size_t)(brow0 + lrow) * ldb + lkc;
  if constexpr (AL::kDma) {
    const int wv = __builtin_amdgcn_readfirstlane(tid >> 6);
    const int fsw = (4 - ((lane >> 4) & 3)) & 3;
    const int lch = ((lane & 3) ^ fsw) * 8;
    const u16* ag0 = al.A + (size_t)(arow0 + 32 * wv + (lane >> 2)) * al.lda + lch;
    const u16* ag1 = ag0 + (size_t)16 * al.lda;
    const u16* bg0 = Bt + (size_t)(brow0 + 32 * wv + (lane >> 2)) * ldb + lch;
    const u16* bg1 = bg0 + (size_t)16 * ldb;
    char* lbase = smem + wv * 2048;
    const int rsw = (4 - ((fr >> 2) & 3)) & 3;
    const int rdo = (fq ^ rsw) << 3;
    const int nk = K >> 5;
    const unsigned lds0 = (unsigned)(size_t)smem;
    const unsigned offA = (unsigned)(((wm * 64 + fr) * 32 + rdo) * 2), offB = (unsigned)(((wn * 64 + fr) * 32 + rdo) * 2);
#define GLDS(KT, ST)                                                                                              \
  {                                                                                                               \
    char* d_ = lbase + (ST) * 16384;                                                                              \
    __builtin_amdgcn_global_load_lds((const u32*)(ag0 + (KT) * 32), (u32*)(d_), 16, 0, 0);                        \
    __builtin_amdgcn_global_load_lds((const u32*)(ag1 + (KT) * 32), (u32*)(d_ + 1024), 16, 0, 0);                 \
    __builtin_amdgcn_global_load_lds((const u32*)(bg0 + (KT) * 32), (u32*)(d_ + 8192), 16, 0, 0);                 \
    __builtin_amdgcn_global_load_lds((const u32*)(bg1 + (KT) * 32), (u32*)(d_ + 8192 + 1024), 16, 0, 0);          \
  }
    __syncthreads();
    GLDS(0, 0);
    GLDS(1, 1);
    int st = 0;
    for (int kt = 0; kt < nk; ++kt) {
      if (kt + 1 < nk) asm volatile("s_waitcnt vmcnt(4)" ::: "memory");
      else asm volatile("s_waitcnt vmcnt(0)" ::: "memory");
      asm volatile("s_waitcnt lgkmcnt(0)" ::: "memory");
      __builtin_amdgcn_s_barrier();
      if (kt + 2 < nk) {
        const int st2 = (st >= 1) ? st - 1 : 2;
        GLDS(kt + 2, st2);
      }
      const unsigned adA = lds0 + st * 16384 + offA, adB = lds0 + st * 16384 + offB;
      bf16x8 af0, af1, af2, af3, bf0, bf1, bf2, bf3;
      asm volatile(
          "ds_read_b128 %0, %8\n\t"
          "ds_read_b128 %1, %8 offset:1024\n\t"
          "ds_read_b128 %2, %8 offset:2048\n\t"
          "ds_read_b128 %3, %8 offset:3072\n\t"
          "ds_read_b128 %4, %9 offset:8192\n\t"
          "ds_read_b128 %5, %9 offset:9216\n\t"
          "ds_read_b128 %6, %9 offset:10240\n\t"
          "ds_read_b128 %7, %9 offset:11264\n\t"
          "s_waitcnt lgkmcnt(0)"
          : "=&v"(af0), "=&v"(af1), "=&v"(af2), "=&v"(af3), "=&v"(bf0), "=&v"(bf1), "=&v"(bf2), "=&v"(bf3)
          : "v"(adA), "v"(adB)
          : "memory");
      const bf16x8 af[4] = {af0, af1, af2, af3};
      const bf16x8 bfr[4] = {bf0, bf1, bf2, bf3};
#pragma unroll
      for (int i = 0; i < 4; ++i)
#pragma unroll
        for (int j = 0; j < 4; ++j) acc[i][j] = __builtin_amdgcn_mfma_f32_16x16x32_bf16(af[i], bfr[j], acc[i][j], 0, 0, 0);
      st = (st == 2) ? 0 : st + 1;
    }
#undef GLDS
  } else {
  u32x4 ra0[4], rb0[4], ra1[4], rb1[4];
#pragma unroll
  for (int i = 0; i < 4; ++i) {
    ra0[i] = al.load(arow0 + lrow + i * 32, lkc);
    rb0[i] = *(const u32x4*)(Bg + (size_t)(i * 32) * ldb);
  }
#pragma unroll
  for (int i = 0; i < 4; ++i) {
    ra1[i] = al.load(arow0 + lrow + i * 32, 64 + lkc);
    rb1[i] = *(const u32x4*)(Bg + (size_t)(i * 32) * ldb + 64);
  }
  const int swz = (fr & 7);
#define GEMM_COMPUTE()                                                                                              \
  {                                                                                                                 \
    bf16x8 af[2][4], bfr[2][4];                                                                                     \
    _Pragma("unroll") for (int ks = 0; ks < 2; ++ks) {                                                              \
      _Pragma("unroll") for (int i = 0; i < 4; ++i) af[ks][i] =                                                     \
          *(const bf16x8*)(sA + (wm * 64 + i * 16 + fr) * LST + (((ks * 4 + fq) ^ swz) << 3));                      \
      _Pragma("unroll") for (int j = 0; j < 4; ++j) bfr[ks][j] =                                                    \
          *(const bf16x8*)(sB + (wn * 64 + j * 16 + fr) * LST + (((ks * 4 + fq) ^ swz) << 3));                      \
    }                                                                                                               \
    _Pragma("unroll") for (int ks = 0; ks < 2; ++ks)                                                                \
    _Pragma("unroll") for (int i = 0; i < 4; ++i) _Pragma("unroll") for (int j = 0; j < 4; ++j) acc[i][j] =         \
        __builtin_amdgcn_mfma_f32_16x16x32_bf16(af[ks][i], bfr[ks][j], acc[i][j], 0, 0, 0);                         \
  }
  for (int k0 = 0; k0 < K; k0 += 128) {
    __syncthreads();
#pragma unroll
    for (int i = 0; i < 4; ++i) {
      *(u32x4*)(sA + (lrow + i * 32) * LST + lkw) = ra0[i];
      *(u32x4*)(sB + (lrow + i * 32) * LST + lkw) = rb0[i];
    }
    __syncthreads();
    if (k0 + 128 < K) {
#pragma unroll
      for (int i = 0; i < 4; ++i) {
        ra0[i] = al.load(arow0 + lrow + i * 32, k0 + 128 + lkc);
        rb0[i] = *(const u32x4*)(Bg + (size_t)(i * 32) * ldb + k0 + 128);
      }
    }
    GEMM_COMPUTE();
    __syncthreads();
#pragma unroll
    for (int i = 0; i < 4; ++i) {
      *(u32x4*)(sA + (lrow + i * 32) * LST + lkw) = ra1[i];
      *(u32x4*)(sB + (lrow + i * 32) * LST + lkw) = rb1[i];
    }
    __syncthreads();
    if (k0 + 192 < K) {
#pragma unroll
      for (int i = 0; i < 4; ++i) {
        ra1[i] = al.load(arow0 + lrow + i * 32, k0 + 192 + lkc);
        rb1[i] = *(const u32x4*)(Bg + (size_t)(i * 32) * ldb + k0 + 192);
      }
    }
    GEMM_COMPUTE();
  }
#undef GEMM_COMPUTE
  }
  float* T = (float*)smem;
  const int mode = epi.mode(n0);
  const bool tr = (mode == 1);
#pragma unroll
  for (int half = 0; half < 2; ++half) {
    __syncthreads();
    if (wm == half) {
      if (!tr) {
#pragma unroll
        for (int i = 0; i < 4; ++i)
#pragma unroll
          for (int j = 0; j < 4; ++j)
#pragma unroll
            for (int e = 0; e < 4; ++e) T[(i * 16 + fq * 4 + e) * 132 + wn * 64 + j * 16 + fr] = acc[i][j][e];
      } else {
#pragma unroll
        for (int i = 0; i < 4; ++i)
#pragma unroll
          for (int j = 0; j < 4; ++j) *(f32x4*)(T + (wn * 64 + j * 16 + fr) * 68 + i * 16 + fq * 4) = acc[i][j];
      }
    }
    __syncthreads();
    if (!tr) {
#pragma unroll
      for (int pass = 0; pass < 4; ++pass) {
        const int lr = pass * 16 + (tid >> 4), c0 = (tid & 15) * 8;
        float v[8];
        f32x4 t0 = *(const f32x4*)(T + lr * 132 + c0), t1 = *(const f32x4*)(T + lr * 132 + c0 + 4);
        v[0] = t0[0]; v[1] = t0[1]; v[2] = t0[2]; v[3] = t0[3];
        v[4] = t1[0]; v[5] = t1[1]; v[6] = t1[2]; v[7] = t1[3];
        epi.row(m0 + half * 64 + lr, n0 + c0, v);
        if (mode == 2) {
          f32x4 w0, w1;
          w0[0] = v[0]; w0[1] = v[1]; w0[2] = v[2]; w0[3] = v[3];
          w1[0] = v[4]; w1[1] = v[5]; w1[2] = v[6]; w1[3] = v[7];
          *(f32x4*)(T + lr * 132 + c0) = w0;
          *(f32x4*)(T + lr * 132 + c0 + 4) = w1;
        }
      }
      if (mode == 2) {
        __syncthreads();
        epi.post(T, m0 + half * 64, n0);
      }
    } else {
#pragma unroll
      for (int pass = 0; pass < 4; ++pass) {
        const int lc = pass * 32 + (tid >> 3), r0 = (tid & 7) * 8;
        float v[8];
        f32x4 t0 = *(const f32x4*)(T + lc * 68 + r0), t1 = *(const f32x4*)(T + lc * 68 + r0 + 4);
        v[0] = t0[0]; v[1] = t0[1]; v[2] = t0[2]; v[3] = t0[3];
        v[4] = t1[0]; v[5] = t1[1]; v[6] = t1[2]; v[7] = t1[3];
        epi.col(n0 + lc, m0 + half * 64 + r0, v);
      }
    }
  }
}

struct EpiEvenIn {
  const Params& p;
  int j;
  DI int mode(int n0) const {
    const int nt = n0 >> 7;
    return (nt >= 4 && nt < 8) ? 1 : ((nt >= 24 && nt < 28) ? 2 : 0);
  }
  DI void row(int r, int c, float* v) const {
    const int nt = c >> 7, cc = c & 127;
    const int b = r / SPB, s = r % SPB;
    u16* dst = ws_P(p) + (size_t)r * EV_IN + c;
    if (nt < 4 || (nt >= 8 && nt < 20)) {
      float ss = 0.f;
#pragma unroll
      for (int e = 0; e < 8; ++e) ss += v[e] * v[e];
      ss = red16(ss);
      const float rstd = rsqrtf(ss * (1.f / 128.f) + EPS);
      const float* g = ((nt < 4) ? p.ev_k_g : p.ev_q_g) + j * 128 + cc;
#pragma unroll
      for (int e = 0; e < 8; ++e) v[e] = v[e] * rstd * g[e];
      if (s >= 256) {
        const int tok = s - 256;
        const float* rc = ws_ROPE(p) + tok * 64 + (cc >> 1);
        const float* rs = rc + 2048 * 64;
#pragma unroll
        for (int e = 0; e < 4; ++e) {
          const float cs = rc[e], sn = rs[e];
          const float x0 = v[2 * e], x1 = v[2 * e + 1];
          v[2 * e] = x0 * cs - x1 * sn;
          v[2 * e + 1] = x0 * sn + x1 * cs;
        }
      }
      if (nt < 4) dst = ws_KB(p) + ((size_t)(b * 4 + nt) * 2304 + s) * 128 + cc;
      else {
#pragma unroll
        for (int e = 0; e < 8; ++e) v[e] *= ATT_CS;
      }
    } else if (nt >= 24 && nt < 28) {
      float ss = 0.f;
#pragma unroll
      for (int e = 0; e < 8; ++e) ss += v[e] * v[e];
      ss = red16(ss);
      const float rstd = rsqrtf(ss * (1.f / 128.f) + EPS);
      const float* g = p.ev_sgu_g + j * 512 + (nt - 24) * 128 + cc;
#pragma unroll
      for (int e = 0; e < 8; ++e) v[e] = v[e] * rstd * g[e];
      return;
    } else if (nt >= 28) {
#pragma unroll
      for (int e = 0; e < 8; ++e) v[e] = siluf_(v[e]);
    }
    *(u32x4*)dst = pack8(v);
  }
  DI void post(float* T, int mrow0, int n0) const {
    const int tid = opaque_tid();
    const int g = (n0 >> 7) - 24, chunk = mrow0 >> 7, roff = mrow0 & 127;
    u16* dst = (u16*)(p.ws + OFF_BVT) + (size_t)(chunk * 4 + g) * 128 * 128;
#pragma unroll
    for (int pass = 0; pass < 4; ++pass) {
      const int lc = pass * 32 + (tid >> 3), r0 = (tid & 7) * 8;
      float v[8];
#pragma unroll
      for (int e = 0; e < 8; ++e) v[e] = T[(r0 + e) * 132 + lc];
      *(u32x4*)(dst + lc * 128 + roff + r0) = pack8(v);
    }
  }
  DI void col(int c, int r0, float* v) const {
    const int kvh = (c >> 7) - 4, d = c & 127;
    const int b = r0 / SPB, s = r0 % SPB;
    *(u32x4*)(ws_VT(p) + ((size_t)(b * 4 + kvh) * 128 + d) * 2304 + s) = pack8(v);
  }
};

struct EpiOddIn {
  const Params& p;
  DI int mode(int) const { return 0; }
  DI void post(float*, int, int) const {}
  DI void row(int r, int c, float* v) const {
    if (c >= OGC) {
#pragma unroll
      for (int e = 0; e < 8; ++e) v[e] = siluf_(v[e]);
    }
    *(u32x4*)(ws_P(p) + (size_t)r * OD_IN + c) = pack8(v);
  }
  DI void col(int, int, float*) const {}
};

struct EpiOut {
  const Params& p;
  int layer;
  DI int mode(int) const { return 0; }
  DI void post(float*, int, int) const {}
  DI void row(int r, int c, float* v) const {
    const int b = r / SPB, s = r % SPB;
    const int mi = (s < 256) ? 4 : b;
    const float* gate = ws_mods(p) + (size_t)(layer * 5 + mi) * 6144 + 4096 + c;
    float* xp = ws_X(p) + (size_t)r * 2048 + c;
    f32x4 x0 = *(const f32x4*)xp, x1 = *(const f32x4*)(xp + 4);
    f32x4 g0 = *(const f32x4*)gate, g1 = *(const f32x4*)(gate + 4);
#pragma unroll
    for (int e = 0; e < 4; ++e) {
      x0[e] += g0[e] * v[e];
      x1[e] += g1[e] * v[4 + e];
    }
    if (layer == 3) {
      if (s >= 256) {
        float* o = p.out + ((size_t)b * 2048 + (s - 256)) * 2048 + c;
        *(f32x4*)o = x0;
        *(f32x4*)(o + 4) = x1;
      }
    } else {
      *(f32x4*)xp = x0;
      *(f32x4*)(xp + 4) = x1;
    }
  }
  DI void col(int, int, float*) const {}
};

struct EpiGlu {
  const Params& p;
  int j;
  DI int mode(int) const { return 0; }
  DI void post(float*, int, int) const {}
  DI void row(int r, int c, float* v) const {
    float yg[8], gc[8];
    unpack8(*(const u32x4*)(ws_YG(p) + (size_t)r * 1024 + c), yg);
    unpack8(*(const u32x4*)(ws_P(p) + (size_t)r * OD_IN + OGC + c), gc);
    const float* gb = p.s5_glu_b + j * 1024 + c;
#pragma unroll
    for (int e = 0; e < 8; ++e) v[e] = yg[e] * sigmoidf_(v[e] + gb[e]) * gc[e];
    *(u32x4*)(ws_MIX(p) + (size_t)r * 2048 + c) = pack8(v);
  }
  DI void col(int, int, float*) const {}
};

struct EpiSgu {
  const Params& p;
  int j;
  DI int mode(int) const { return 0; }
  DI void post(float*, int, int) const {}
  DI void row(int r, int c, float* v) const {
    const u16* P = ws_P(p);
    const float bsv = p.ev_bs[(j * 4 + (c >> 7)) * 128 + (r & 127)];
    float u[8], gb[8];
    unpack8(*(const u32x4*)(P + (size_t)r * EV_IN + EBU + c), u);
    unpack8(*(const u32x4*)(P + (size_t)r * EV_IN + EGB + c), gb);
#pragma unroll
    for (int e = 0; e < 8; ++e) v[e] = u[e] * (v[e] + bsv) * gb[e];
    *(u32x4*)(ws_MIX(p) + (size_t)r * 2048 + 1536 + c) = pack8(v);
  }
  DI void col(int, int, float*) const {}
};

struct ConvA {
  static constexpr bool kDma = false;
  const Params& p;
  int jl, h;
  const u16* A = nullptr;
  int lda = 0;
  DI void conv8(int r, int ch, float* a) const {
    const int b = r / SPB, s = r % SPB;
    const int lo = (s < 256) ? 0 : 256, hi = (s < 256) ? 256 : 2304;
    const u16* P = ws_P(p);
    const f32x4 b0 = *(const f32x4*)(p.lru_conv_b + jl * 1024 + ch), b1 = *(const f32x4*)(p.lru_conv_b + jl * 1024 + ch + 4);
    a[0] = b0[0]; a[1] = b0[1]; a[2] = b0[2]; a[3] = b0[3];
    a[4] = b1[0]; a[5] = b1[1]; a[6] = b1[2]; a[7] = b1[3];
#pragma unroll
    for (int kk = 0; kk < 4; ++kk) {
      const int ss = s + kk - 1;
      if (ss >= lo && ss < hi) {
        float x[8];
        unpack8(*(const u32x4*)(P + (size_t)(b * SPB + ss) * OD_IN + OXD + ch), x);
        const float* w = p.lru_conv_w + (jl * 4 + kk) * 1024 + ch;
        const f32x4 w0 = *(const f32x4*)w, w1 = *(const f32x4*)(w + 4);
        a[0] += w0[0] * x[0]; a[1] += w0[1] * x[1]; a[2] += w0[2] * x[2]; a[3] += w0[3] * x[3];
        a[4] += w1[0] * x[4]; a[5] += w1[1] * x[5]; a[6] += w1[2] * x[6]; a[7] += w1[3] * x[7];
      }
    }
  }
  DI u32x4 load(int row, int k) const {
    float a[8];
    conv8(row, h * 128 + k, a);
    return pack8(a);
  }
};

struct EpiLru {
  const Params& p;
  int jl, h;
  DI int mode(int) const { return 2; }
  DI void row(int r, int c, float* v) const {
    const int dir = c >> 8, j0 = ((c & 255) >> 3) * 4;
    const int ch = h * 128 + j0;
    float xc[8];
    {
      const u32x2 xq = *(const u32x2*)((const u16*)(p.ws + OFF_XC) + (size_t)r * 1024 + ch);
      xc[0] = blo(xq[0]); xc[1] = bhi(xq[0]); xc[2] = blo(xq[1]); xc[3] = bhi(xq[1]);
    }
    const int xo = 0;
    const int pi = (jl * 2 + dir) * 1024 + ch;
    const f32x4 ba = *(const f32x4*)(p.lru_ba + pi), bx = *(const f32x4*)(p.lru_bx + pi);
    const f32x4 c8 = *(const f32x4*)((const float*)(p.ws + OFF_C8) + pi);
    f32x4 av, bv;
#pragma unroll
    for (int e = 0; e < 4; ++e) {
      const float rg = __builtin_amdgcn_rcpf(1.f + __expf(-(v[e] + ba[e])));
      const float ig = __builtin_amdgcn_rcpf(1.f + __expf(-(v[4 + e] + bx[e])));
      const float la = c8[e] * rg;
      av[e] = __expf(la);
      const float x = 2.f * la;
      const float om = -x * (1.f + x * (0.5f + x * (0.16666667f + x * (0.041666668f + x * (0.008333334f + x * 0.0013888889f)))));
      bv[e] = __builtin_amdgcn_sqrtf(om) * (ig * xc[xo + e]);
    }
    __builtin_nontemporal_store(av, (f32x4*)(ws_LA(p) + ((size_t)dir * ROWS + r) * 1024 + ch));
    __builtin_nontemporal_store(bv, (f32x4*)(ws_LB(p) + ((size_t)dir * ROWS + r) * 1024 + ch));
#pragma unroll
    for (int e = 0; e < 4; ++e) {
      v[e] = av[e];
      v[4 + e] = bv[e];
    }
  }
  DI void post(float* T, int mrow0, int n0) const {
    const int tid = opaque_tid();
    const int dir = n0 >> 8, jhalf = (n0 >> 7) & 1;
    const int cq = tid >> 6, jj = tid & 63;
    const int ca = 8 * (jj >> 2) + (jj & 3);
    float Ap = 1.f, Bp = 0.f;
#pragma unroll
    for (int k = 0; k < 16; ++k) {
      const int rr = cq * 16 + (dir ? 15 - k : k);
      const float a = T[rr * 132 + ca], b = T[rr * 132 + ca + 4];
      Bp = a * Bp + b;
      Ap *= a;
    }
    const int b_ = mrow0 / SPB, chunk = (mrow0 % SPB) / 16 + cq;
    const size_t si = (((size_t)dir * 4 + b_) * 144 + chunk) * 1024 + h * 128 + jhalf * 64 + jj;
    ws_SA(p)[si] = Ap;
    ws_SB(p)[si] = Bp;
  }
  DI void col(int, int, float*) const {}
};

DI void tile_remap(int item, int nb, int total, int NT, int& mt, int& nt) {
  int v = item;
  if ((nb & 7) == 0) {
    const int k = item / nb;
    if (k < total / nb) {
      const int bid = item % nb;
      v = k * nb + (bid & 7) * (nb >> 3) + (bid >> 3);
    }
  }
  const int q = v >> 5, t = v & 31, nrn = NT >> 2;
  mt = (q / nrn) * 8 + (t >> 2);
  nt = (q % nrn) * 4 + (t & 3);
}

__device__ void phase_gemm_in(const Params& p, int layer, int bid, int nb, char* smem) {
  const int j = layer >> 1;
  if ((layer & 1) == 0) {
    EpiEvenIn epi{p, j};
    const u16* W = (const u16*)(p.ws + OFF_WEVIN) + (size_t)j * EV_IN * 2048;
    constexpr int NT = EV_IN / 128;
    const PlainA al{ws_H(p), 2048};
    for (int item = bid; item < 72 * NT; item += nb) {
      int mt, nt;
      tile_remap(item, nb, 72 * NT, NT, mt, nt);
      gemm_tile(al, mt * 128, W, 2048, nt * 128, 2048, mt * 128, nt * 128, smem, epi);
    }
  } else {
    EpiOddIn epi{p};
    const u16* W = (const u16*)(p.ws + OFF_WODIN) + (size_t)j * OD_IN * 2048;
    constexpr int NT = OD_IN / 128;
    const PlainA al{ws_H(p), 2048};
    for (int item = bid; item < 72 * NT; item += nb) {
      int mt, nt;
      tile_remap(item, nb, 72 * NT, NT, mt, nt);
      gemm_tile(al, mt * 128, W, 2048, nt * 128, 2048, mt * 128, nt * 128, smem, epi);
    }
  }
}

__device__ void phase_gemm_out(const Params& p, int layer, int bid, int nb, char* smem) {
  const int j = layer >> 1;
  EpiOut epi{p, layer};
  const u16* W = (const u16*)(p.ws + ((layer & 1) ? OFF_WODOUT : OFF_WEVOUT)) + (size_t)j * 2048 * 2048;
  const PlainA al{ws_MIX(p), 2048};
  const int nmt = (layer == 3) ? 64 : 72;
  for (int item = bid; item < nmt * 16; item += nb) {
    int mt, nt;
    tile_remap(item, nb, nmt * 16, 16, mt, nt);
    if (layer == 3) mt = (mt >> 4) * 18 + 2 + (mt & 15);
    gemm_tile(al, mt * 128, W, 2048, nt * 128, 2048, mt * 128, nt * 128, smem, epi);
  }
}

#define MFMA32(a, b, c) __builtin_amdgcn_mfma_f32_32x32x16_bf16((a), (b), (c), 0, 0, 0)

DI void attn_flash_item(const Params& p, int b, int h, int qb, char* smem) {
  const int tid = opaque_tid(), lane = tid & 63, wave = tid >> 6, l31 = lane & 31, hh = lane >> 5;
  const int kvh = h / 3;
  const int ntiles = (qb < 2) ? 4 : 36;
  u16* Ks = (u16*)smem;
  u16* Vs = Ks + 64 * 136;
  const u16* Kg = ws_KB(p) + (size_t)(b * 4 + kvh) * 2304 * 128;
  const u16* Vg = ws_VT(p) + (size_t)(b * 4 + kvh) * 128 * 2304;
  const int r = b * SPB + qb * 128 + wave * 32 + l31;
  bf16x8 qf[8];
  {
    const u16* qp = ws_P(p) + (size_t)r * EV_IN + EQ + h * 128 + hh * 8;
#pragma unroll
    for (int s = 0; s < 8; ++s) qf[s] = *(const bf16x8*)(qp + s * 16);
  }
  f32x16 ot[4];
#pragma unroll
  for (int db = 0; db < 4; ++db)
#pragma unroll
    for (int i = 0; i < 16; ++i) ot[db][i] = 0.f;
  float m = -1e30f, l = 0.f;
  const int kkey = tid >> 4, kch = (tid & 15) * 8;
  const int vd = tid >> 3, vch = (tid & 7) * 8;
  u32x4 kr[4], vr[4];
#pragma unroll
  for (int i = 0; i < 4; ++i) {
    kr[i] = *(const u32x4*)(Kg + (size_t)(kkey + 16 * i) * 128 + kch);
    vr[i] = *(const u32x4*)(Vg + (size_t)(vd + 32 * i) * 2304 + vch);
  }
  for (int t = 0; t < ntiles; ++t) {
    __syncthreads();
#pragma unroll
    for (int i = 0; i < 4; ++i) {
      *(u32x4*)(Ks + (kkey + 16 * i) * 136 + kch) = kr[i];
      u32x2 lo, hi;
      lo[0] = vr[i][0]; lo[1] = vr[i][1]; hi[0] = vr[i][2]; hi[1] = vr[i][3];
      *(u32x2*)(Vs + (vd + 32 * i) * 68 + vch) = lo;
      *(u32x2*)(Vs + (vd + 32 * i) * 68 + vch + 4) = hi;
    }
    __syncthreads();
    if (t + 1 < ntiles) {
#pragma unroll
      for (int i = 0; i < 4; ++i) {
        kr[i] = *(const u32x4*)(Kg + (size_t)((t + 1) * 64 + kkey + 16 * i) * 128 + kch);
        vr[i] = *(const u32x4*)(Vg + (size_t)(vd + 32 * i) * 2304 + (t + 1) * 64 + vch);
      }
    }
    f32x16 st[2];
#pragma unroll
    for (int kb = 0; kb < 2; ++kb) {
#pragma unroll
      for (int i = 0; i < 16; ++i) st[kb][i] = 0.f;
#pragma unroll
      for (int s = 0; s < 8; ++s) {
        bf16x8 ka = *(const bf16x8*)(Ks + (kb * 32 + l31) * 136 + s * 16 + hh * 8);
        st[kb] = MFMA32(ka, qf[s], st[kb]);
      }
    }
    float mx = st[0][0];
#pragma unroll
    for (int i = 1; i < 16; ++i) mx = fmaxf(mx, st[0][i]);
#pragma unroll
    for (int i = 0; i < 16; ++i) mx = fmaxf(mx, st[1][i]);
    {
      const auto rr = __builtin_amdgcn_permlane32_swap(__float_as_uint(mx), __float_as_uint(mx), false, false);
      mx = fmaxf(__uint_as_float(rr[0]), __uint_as_float(rr[1]));
    }
    constexpr float THR2 = 8.f * 1.4426950408889634f;
    if (__builtin_amdgcn_ballot_w64(mx - m > THR2) != 0ull) {
      const float mnew = fmaxf(m, mx);
      const float alpha = __builtin_amdgcn_exp2f(m - mnew);
      l *= alpha;
#pragma unroll
      for (int db = 0; db < 4; ++db)
#pragma unroll
        for (int i = 0; i < 16; ++i) ot[db][i] *= alpha;
      m = mnew;
    }
    float ls = 0.f;
#pragma unroll
    for (int kb = 0; kb < 2; ++kb)
#pragma unroll
      for (int i = 0; i < 16; ++i) {
        const float pv = __builtin_amdgcn_exp2f(st[kb][i] - m);
        st[kb][i] = pv;
        ls += pv;
      }
    l += ls;
#pragma unroll
    for (int kb = 0; kb < 2; ++kb)
#pragma unroll
      for (int s = 0; s < 2; ++s) {
        u32x4 pq;
        asm volatile(
            "v_cvt_pk_bf16_f32 %0, %4, %5\n\tv_cvt_pk_bf16_f32 %1, %6, %7\n\tv_cvt_pk_bf16_f32 %2, %8, %9\n\tv_cvt_pk_bf16_f32 %3, "
            "%10, %11\n\ts_nop 1"
            : "=&v"(pq[0]), "=&v"(pq[1]), "=&v"(pq[2]), "=&v"(pq[3])
            : "v"(st[kb][8 * s]), "v"(st[kb][8 * s + 1]), "v"(st[kb][8 * s + 2]), "v"(st[kb][8 * s + 3]),
              "v"(st[kb][8 * s + 4]), "v"(st[kb][8 * s + 5]), "v"(st[kb][8 * s + 6]), "v"(st[kb][8 * s + 7]));
        const bf16x8 pb = __builtin_bit_cast(bf16x8, pq);
#pragma unroll
        for (int db = 0; db < 4; ++db) {
          const u16* vp = Vs + (db * 32 + l31) * 68 + kb * 32 + s * 16 + hh * 4;
          const u32x2 a0 = *(const u32x2*)vp, a1 = *(const u32x2*)(vp + 8);
          u32x4 aq;
          aq[0] = a0[0]; aq[1] = a0[1]; aq[2] = a1[0]; aq[3] = a1[1];
          ot[db] = MFMA32(__builtin_bit_cast(bf16x8, aq), pb, ot[db]);
        }
      }
  }
  l += __shfl_xor(l, 32);
  const float linv = 1.f / l;
  const u16* gap = ws_P(p) + (size_t)r * EV_IN + EGA + h * 128;
  u16* op = ws_MIX(p) + (size_t)r * 2048 + h * 128;
#pragma unroll
  for (int db = 0; db < 4; ++db)
#pragma unroll
    for (int i4 = 0; i4 < 4; ++i4) {
      const int d0 = db * 32 + 8 * i4 + 4 * hh;
      const u32x2 g = *(const u32x2*)(gap + d0);
      u32x2 o;
      o[0] = pk(ot[db][4 * i4] * linv * blo(g[0]), ot[db][4 * i4 + 1] * linv * bhi(g[0]));
      o[1] = pk(ot[db][4 * i4 + 2] * linv * blo(g[1]), ot[db][4 * i4 + 3] * linv * bhi(g[1]));
      *(u32x2*)(op + d0) = o;
    }
}

__device__ void phase_even_mix(const Params& p, int layer, int bid, int nb, char* smem) {
  const int j = layer >> 1;
  constexpr int N_ATT = 864;
  constexpr int N_SGU = 288;
  EpiSgu epi{p, j};
  const int nfull = 768 / nb * nb;
  const int nlow = (768 - nfull < nb) ? 768 - nfull : nb;
  const int nhi = nb - nlow;
  const bool split = nhi > 0 && nlow > 0;
  for (int k = 0;; ++k) {
    int item;
    if (!split) {
      item = bid + k * nb;
    } else {
      const int hk = bid + k * nb;
      if (hk < 768) item = hk;
      else {
        if (bid < nlow) break;
        const int kh = (768 - bid + nb - 1) / nb;
        item = 768 + (bid - nlow) + (k - kh) * nhi;
      }
    }
    if (item >= N_ATT + N_SGU) break;
    if (item < N_ATT) {
      int qb, bh;
      if (item < 768) {
        qb = 2 + (item & 15);
        bh = item >> 4;
      } else {
        qb = (item - 768) & 1;
        bh = (item - 768) >> 1;
      }
      attn_flash_item(p, bh / 12, bh % 12, qb, smem);
    } else {
      const int it = item - N_ATT, chunk = it >> 2, g = it & 3;
      const PlainA al{(const u16*)(p.ws + OFF_WSB) + (size_t)(j * 4 + g) * 128 * 128, 128};
      const u16* Bt = (const u16*)(p.ws + OFF_BVT) + (size_t)(chunk * 4 + g) * 128 * 128;
      gemm_tile(al, 0, Bt, 128, 0, 128, chunk * 128, g * 128, smem, epi);
    }
  }
}

#define MFMA16(a, b, c) __builtin_amdgcn_mfma_f32_16x16x32_bf16((a), (b), (c), 0, 0, 0)
#define LDS_FENCE() asm volatile("s_waitcnt lgkmcnt(0)" ::: "memory")
constexpr int S5_DT = 20;
constexpr int S5_WAVE_LDS = 128 * S5_DT * 4;

struct S5W {
  float ar, ai;
  bf16x8 bb[8];
};

DI void s5_wave_setup(const Params& p, int jl, int dir, int g, int lane, S5W& w) {
  const size_t gi = (size_t)(jl * 2 + dir) * 64 + g;
  const float lre = p.s5_lam_re[gi * 64 + lane], lim = p.s5_lam_im[gi * 64 + lane];
  const float dt = expf(p.s5_log_dt[gi]);
  const float mag = expf(lre * dt);
  const float ang = lim * dt;
  w.ar = mag * cosf(ang);
  w.ai = mag * sinf(ang);
  const float xr = w.ar - 1.f, xi = w.ai;
  const float den = lre * lre + lim * lim;
  const float cr = (xr * lre + xi * lim) / den, ci = (xi * lre - xr * lim) / den;
  const int col = lane & 15, quad = lane >> 4;
#pragma unroll
  for (int nt = 0; nt < 8; ++nt) {
    const int nidx = nt * 16 + col, n = nidx & 63;
    const float crn = __shfl(cr, n), cin = __shfl(ci, n);
    u32x4 q;
    q[0] = 0u; q[1] = 0u; q[2] = 0u; q[3] = 0u;
    if (quad < 2) {
      const float* br = p.s5_b_re + (gi * 64 + n) * 16 + quad * 8;
      const float* bi = p.s5_b_im + (gi * 64 + n) * 16 + quad * 8;
      const f32x4 r0 = *(const f32x4*)br, r1 = *(const f32x4*)(br + 4), i0 = *(const f32x4*)bi, i1 = *(const f32x4*)(bi + 4);
      float v[8];
#pragma unroll
      for (int e = 0; e < 4; ++e) {
        v[e] = (nt < 4) ? (crn * r0[e] - cin * i0[e]) : (crn * i0[e] + cin * r0[e]);
        v[4 + e] = (nt < 4) ? (crn * r1[e] - cin * i1[e]) : (crn * i1[e] + cin * r1[e]);
      }
      q = pack8(v);
    }
    w.bb[nt] = __builtin_bit_cast(bf16x8, q);
  }
}

DI void s5_readout_frags(const Params& p, int jl, int dir, int g, int lane, bf16x8* cm) {
  const size_t gi = (size_t)(jl * 2 + dir) * 64 + g;
  const int col = lane & 15, quad = lane >> 4;
#pragma unroll
  for (int ks = 0; ks < 4; ++ks) {
    const int n0 = ks * 16 + quad * 4;
    const f32x4 cr = *(const f32x4*)(p.s5_c_re + (gi * 16 + col) * 64 + n0);
    const f32x4 ci = *(const f32x4*)(p.s5_c_im + (gi * 16 + col) * 64 + n0);
    float v[8];
#pragma unroll
    for (int e = 0; e < 4; ++e) {
      v[2 * e] = cr[e];
      v[2 * e + 1] = -ci[e];
    }
    cm[ks] = __builtin_bit_cast(bf16x8, pack8(v));
  }
}

DI void s5_table_store(const Params& p, int jl, int dir, int g, int lane) {
  S5W w;
  bf16x8 cm[4];
  s5_wave_setup(p, jl, dir, g, lane, w);
  s5_readout_frags(p, jl, dir, g, lane, cm);
  u32* T = (u32*)(p.ws + OFF_S5T) + (size_t)((jl * 2 + dir) * 64 + g) * S5T_WORDS;
  T[lane] = __float_as_uint(w.ar);
  T[64 + lane] = __float_as_uint(w.ai);
#pragma unroll
  for (int nt = 0; nt < 8; ++nt) *(u32x4*)(T + 128 + (nt * 64 + lane) * 4) = __builtin_bit_cast(u32x4, w.bb[nt]);
#pragma unroll
  for (int ks = 0; ks < 4; ++ks) *(u32x4*)(T + 128 + 2048 + (ks * 64 + lane) * 4) = __builtin_bit_cast(u32x4, cm[ks]);
}
DI void s5_table_load(const Params& p, int jl, int dir, int g, int lane, S5W& w) {
  const u32* T = (const u32*)(p.ws + OFF_S5T) + (size_t)((jl * 2 + dir) * 64 + g) * S5T_WORDS;
  w.ar = __uint_as_float(T[lane]);
  w.ai = __uint_as_float(T[64 + lane]);
#pragma unroll
  for (int nt = 0; nt < 8; ++nt) w.bb[nt] = __builtin_bit_cast(bf16x8, *(const u32x4*)(T + 128 + (nt * 64 + lane) * 4));
}
DI void s5_table_load_cm(const Params& p, int jl, int dir, int g, int lane, bf16x8* cm) {
  const u32* T = (const u32*)(p.ws + OFF_S5T) + (size_t)((jl * 2 + dir) * 64 + g) * S5T_WORDS;
#pragma unroll
  for (int ks = 0; ks < 4; ++ks) cm[ks] = __builtin_bit_cast(bf16x8, *(const u32x4*)(T + 128 + 2048 + (ks * 64 + lane) * 4));
}

template <bool READ, int DIR>
DI void s5_run(const S5W& w, const bf16x8* cm, const u16* ug, float* Dt, float& hr, float& hi, f32x4* yacc, int lane) {
  const int col = lane & 15, quad = lane >> 4;
  u32x4 uq;
  uq[0] = 0u; uq[1] = 0u; uq[2] = 0u; uq[3] = 0u;
  if (quad < 2) uq = *(const u32x4*)(ug + (size_t)((DIR ? 7 : 0) * 16) * OD_IN);
#pragma unroll
  for (int bi = 0; bi < 8; ++bi) {
    const int bk = DIR ? 7 - bi : bi;
    const bf16x8 ua = __builtin_bit_cast(bf16x8, uq);
    if (bi < 7 && quad < 2) uq = *(const u32x4*)(ug + (size_t)((DIR ? bk - 1 : bk + 1) * 16) * OD_IN);
#pragma unroll
    for (int nt = 0; nt < 8; ++nt) {
      const f32x4 d = MFMA16(ua, w.bb[nt], (f32x4{0.f, 0.f, 0.f, 0.f}));
      *(f32x4*)(Dt + (nt * 16 + col) * S5_DT + quad * 4) = d;
    }
    LDS_FENCE();
#pragma unroll 1
    for (int s4 = 0; s4 < 4; ++s4) {
      const int tb = (DIR ? 3 - s4 : s4) * 4;
      const f32x4 dr = *(const f32x4*)(Dt + lane * S5_DT + tb);
      const f32x4 di = *(const f32x4*)(Dt + (64 + lane) * S5_DT + tb);
      u32x4 hp;
#pragma unroll
      for (int e = 0; e < 4; ++e) {
        const int ix = DIR ? 3 - e : e;
        const float nr = w.ar * hr - w.ai * hi + dr[ix], ni = w.ar * hi + w.ai * hr + di[ix];
        hr = nr;
        hi = ni;
        if (READ) hp[ix] = pk(hr, hi);
      }
      if (READ) *(u32x4*)(Dt + lane * S5_DT + tb) = hp;
    }
    if (READ) {
      LDS_FENCE();
      const u32* Hw = (const u32*)Dt;
#pragma unroll
      for (int ks = 0; ks < 4; ++ks) {
        u32x4 hq;
#pragma unroll
        for (int jj = 0; jj < 4; ++jj) hq[jj] = Hw[(ks * 16 + quad * 4 + jj) * S5_DT + col];
        yacc[bk] = MFMA16(__builtin_bit_cast(bf16x8, hq), cm[ks], yacc[bk]);
      }
    }
    LDS_FENCE();
  }
}

__device__ void phase_odd3(const Params& p, int layer, int bid, int nb, char* smem) {
  const int jl = layer >> 1;
  const int tid = opaque_tid(), lane = tid & 63, wave = tid >> 6;
  constexpr int N_CONV = 4608;
  constexpr int N_S5A = 2304;
  for (int item = bid; item < N_CONV + N_S5A; item += nb) {
    if (item < N_S5A) {
      const int w = item * 4 + wave;
      const int seg = w % 18, dir = (w / 18) & 1, g = (w / 36) & 63, b = w / (36 * 64);
      float* D = (float*)(smem + wave * S5_WAVE_LDS);
      const u16* ug = ws_P(p) + (size_t)(b * SPB + seg * 128 + (lane & 15)) * OD_IN + g * 16 + (lane >> 4) * 8;
      S5W q;
      s5_table_load(p, jl, dir, g, lane, q);
      float hr = 0.f, hi = 0.f;
      if (dir) s5_run<false, 1>(q, nullptr, ug, D, hr, hi, nullptr, lane);
      else s5_run<false, 0>(q, nullptr, ug, D, hr, hi, nullptr, lane);
      float* E = ws_E(p) + ((((size_t)dir * 4 + b) * 64 + g) * 18 + seg) * 128;
      E[lane * 2] = hr;
      E[lane * 2 + 1] = hi;
    } else {
      const int id = (item - N_S5A) * 256 + tid;
      const int r = id >> 7, ch = (id & 127) * 8;
      const ConvA ca{p, jl, ch >> 7};
      float a8[8];
      ca.conv8(r, ch, a8);
      *(u32x4*)((u16*)(p.ws + OFF_XC) + (size_t)r * 1024 + ch) = pack8(a8);
    }
  }
}

__device__ __forceinline__ void phase_odd3b(const Params& p, int layer, int bid, int nb, char* smem) {
  const int jl = layer >> 1;
  constexpr int N_LRU = 72 * 8 * 4;
  for (int item = bid; item < N_LRU; item += nb) {
    const int ntile = item & 3, h = (item >> 2) & 7, mt = item >> 5;
    const PlainA al{(const u16*)(p.ws + OFF_XC) + h * 128, 1024};
    EpiLru epi{p, jl, h};
    const u16* Bt = (const u16*)(p.ws + OFF_WLRU) + (size_t)(jl * 8 + h) * 512 * 128;
    gemm_tile(al, mt * 128, Bt, 128, ntile * 128, 128, mt * 128, ntile * 128, smem, epi);
  }
}

DI int s5_order_seg(int dir, int pos) { return dir ? (pos < 2 ? 1 - pos : 19 - pos) : pos; }
DI int s5_order_pos(int dir, int seg) { return dir ? (seg < 2 ? 1 - seg : 19 - seg) : seg; }

DI void s5_init_state(const Params& p, const S5W& q, int dir, int b, int g, int seg, int lane, float& hr, float& hi) {
  float pr = q.ar, pi_ = q.ai;
#pragma unroll
  for (int k = 0; k < 7; ++k) {
    const float nr = pr * pr - pi_ * pi_, ni = 2.f * pr * pi_;
    pr = nr;
    pi_ = ni;
  }
  hr = 0.f;
  hi = 0.f;
  const int mypos = s5_order_pos(dir, seg);
  const float* E = ws_E(p) + (((size_t)dir * 4 + b) * 64 + g) * 18 * 128;
  float er[17], ei[17];
#pragma unroll
  for (int pos = 0; pos < 17; ++pos) {
    const int sg = s5_order_seg(dir, pos);
    const float2 ev = *(const float2*)(E + sg * 128 + lane * 2);
    er[pos] = ev.x;
    ei[pos] = ev.y;
  }
#pragma unroll
  for (int pos = 0; pos < 17; ++pos) {
    if (pos < mypos) {
      const float nr = pr * hr - pi_ * hi + er[pos], ni = pr * hi + pi_ * hr + ei[pos];
      hr = nr;
      hi = ni;
    }
  }
}

constexpr int LRU_FIN_PER = 4;
DI unsigned xb_ld(unsigned* p);
DI unsigned xb_add(unsigned* p, unsigned v);
DI void lru_final_item(const Params& p, int it, int tid) {
  const u16* P = ws_P(p);
  const int bc = it >> 2, ch = (it & 3) * 256 + tid;
  const int b = bc / 144, c = bc % 144;
  const int r0 = bc * 16;
  const size_t ci = ((size_t)b * 144 + c) * 1024 + ch;
  const float* LA0 = ws_LA(p) + (size_t)r0 * 1024 + ch;
  const float* LB0 = ws_LB(p) + (size_t)r0 * 1024 + ch;
  const float* LA1 = LA0 + (size_t)ROWS * 1024;
  const float* LB1 = LB0 + (size_t)ROWS * 1024;
  float hf[16];
  float h = ws_CIN(p)[ci];
#pragma unroll
  for (int t = 0; t < 16; ++t) {
    h = __builtin_nontemporal_load(LA0 + (size_t)t * 1024) * h + __builtin_nontemporal_load(LB0 + (size_t)t * 1024);
    hf[t] = h;
  }
  h = ws_CIN(p)[(size_t)4 * 144 * 1024 + ci];
#pragma unroll
  for (int tt = 0; tt < 16; ++tt) {
    const int t = 15 - tt;
    h = __builtin_nontemporal_load(LA1 + (size_t)t * 1024) * h + __builtin_nontemporal_load(LB1 + (size_t)t * 1024);
    const float gd = bf2f(P[(size_t)(r0 + t) * OD_IN + OGD + ch]);
    ws_MIX(p)[(size_t)(r0 + t) * 2048 + 1024 + ch] = f2bf((hf[t] + h) * gd);
  }
}

__device__ void phase_odd4(const Params& p, int layer, int bid, int nb, char* smem) {
  const int jl = layer >> 1;
  const int tid = opaque_tid(), lane = tid & 63, wave = tid >> 6;
  constexpr int N_CAR = 32;
  constexpr int N_S5B = 1152;
  constexpr int N_FIN = 2304;
  unsigned* carry_done = (unsigned*)(p.ws + OFF_BAR) + 64 + jl;
  for (int item = bid; item < N_CAR + N_S5B; item += nb) {
    if (item < N_CAR) {
      const int id = item * 256 + tid;
      const int ch = id & 1023, b = (id >> 10) & 3, dir = id >> 12;
      const float* SA = ws_SA(p) + ((size_t)dir * 4 + b) * 144 * 1024 + ch;
      const float* SBp = ws_SB(p) + ((size_t)dir * 4 + b) * 144 * 1024 + ch;
      float* CI = ws_CIN(p) + ((size_t)dir * 4 + b) * 144 * 1024 + ch;
      float h = 0.f;
#pragma unroll 8
      for (int k = 0; k < 144; ++k) {
        const int c = dir ? (k < 16 ? 15 - k : 159 - k) : k;
        CI[(size_t)c * 1024] = h;
        h = SA[(size_t)c * 1024] * h + SBp[(size_t)c * 1024];
      }
      asm volatile("s_waitcnt vmcnt(0)" ::: "memory");
      __syncthreads();
      if (tid == 0) {
        __builtin_amdgcn_fence(__ATOMIC_RELEASE, "agent");
        asm volatile("s_waitcnt vmcnt(0)" ::: "memory");
        (void)xb_add(carry_done, 1u);
      }
    } else {
      const int w = (item - N_CAR) * 4 + wave;
      const int seg = w % 18, g = (w / 18) & 63, b = w / (18 * 64);
      float* D = (float*)(smem + wave * S5_WAVE_LDS);
      const size_t row0 = (size_t)(b * SPB + seg * 128);
      const u16* ug = ws_P(p) + (row0 + (lane & 15)) * OD_IN + g * 16 + (lane >> 4) * 8;
      f32x4 yacc[8];
#pragma unroll
      for (int k = 0; k < 8; ++k) yacc[k] = f32x4{0.f, 0.f, 0.f, 0.f};
      {
        S5W q;
        bf16x8 cm[4];
        s5_table_load(p, jl, 0, g, lane, q);
        s5_table_load_cm(p, jl, 0, g, lane, cm);
        float hr, hi;
        s5_init_state(p, q, 0, b, g, seg, lane, hr, hi);
        s5_run<true, 0>(q, cm, ug, D, hr, hi, yacc, lane);
      }
      {
        S5W q;
        bf16x8 cm[4];
        s5_table_load(p, jl, 1, g, lane, q);
        s5_table_load_cm(p, jl, 1, g, lane, cm);
        float hr, hi;
        s5_init_state(p, q, 1, b, g, seg, lane, hr, hi);
        s5_run<true, 1>(q, cm, ug, D, hr, hi, yacc, lane);
      }
      const int col = lane & 15, quad = lane >> 4;
#pragma unroll
      for (int bk = 0; bk < 8; ++bk)
#pragma unroll
        for (int j = 0; j < 4; ++j) D[(bk * 16 + quad * 4 + j) * 16 + col] = yacc[bk][j];
      LDS_FENCE();
      u16* YG = ws_YG(p);
      const u16* P = ws_P(p);
#pragma unroll
      for (int i = 0; i < 4; ++i) {
        const int id = lane + 64 * i, t = id >> 1, hf = id & 1;
        float u[8], y[8];
        unpack8(*(const u32x4*)(P + (row0 + t) * OD_IN + g * 16 + hf * 8), u);
        const f32x4 y0 = *(const f32x4*)(D + t * 16 + hf * 8), y1 = *(const f32x4*)(D + t * 16 + hf * 8 + 4);
        const float* dsk = p.s5_d + jl * 1024 + g * 16 + hf * 8;
#pragma unroll
        for (int e = 0; e < 8; ++e) {
          const float yy = ((e < 4) ? y0[e & 3] : y1[e & 3]) + dsk[e] * u[e];
          y[e] = 0.5f * yy * (1.f + tanhf(0.7978845608028654f * (yy + 0.044715f * yy * yy * yy)));
        }
        *(u32x4*)(YG + (row0 + t) * 1024 + g * 16 + hf * 8) = pack8(y);
      }
      LDS_FENCE();
    }
  }
  const int rem = (N_CAR + N_S5B) % nb;
  if (rem > 0 && bid >= rem) {
    const int nshort = nb - rem;
    if (tid == 0) {
      unsigned sp = 0;
      while (xb_ld(carry_done) < (unsigned)N_CAR && sp < (1u << 22)) {
        __builtin_amdgcn_s_sleep(2);
        ++sp;
      }
      __builtin_amdgcn_fence(__ATOMIC_ACQUIRE, "agent");
      asm volatile("s_waitcnt vmcnt(0)" ::: "memory");
    }
    __syncthreads();
    for (int j = 0; j < LRU_FIN_PER; ++j) {
      const int it = (bid - rem) + j * nshort;
      if (it < N_FIN) lru_final_item(p, it, tid);
    }
  }
}

__device__ void phase_odd5(const Params& p, int layer, int bid, int nb, char* smem) {
  const int jl = layer >> 1;
  constexpr int N_GLU = 72 * 8;
  EpiGlu epi{p, jl};
  const u16* W = (const u16*)(p.ws + OFF_WGLU) + (size_t)jl * 1024 * 1024;
  const PlainA al{ws_YG(p), 1024};
  const int tid = opaque_tid();
  const int rem = (32 + 1152) % nb;
  int n4 = (rem > 0) ? LRU_FIN_PER * (nb - rem) : 0;
  if (n4 > 2304) n4 = 2304;
  for (int item = bid; item < N_GLU + (2304 - n4); item += nb) {
    if (item < N_GLU) {
      int mt, nt;
      tile_remap(item, nb, N_GLU, 8, mt, nt);
      gemm_tile(al, mt * 128, W, 1024, nt * 128, 1024, mt * 128, nt * 128, smem, epi);
    } else {
      lru_final_item(p, n4 + item - N_GLU, tid);
    }
  }
}

#define XB_TMO 128
#define XB_XCNT(j) (256 + 64 * (j))
#define XB_XSUB(j) (1280 + 64 * (j))
#define XB_XGEN(j) (2304 + 64 * (j))
#define XB_TOP 3328
#define XB_TOPGEN 3392
#define XB_SPIN_CAP (1u << 20)
#define LAS __attribute__((address_space(3)))
DI unsigned xb_ld(unsigned* p) { return __hip_atomic_load(p, __ATOMIC_RELAXED, __HIP_MEMORY_SCOPE_AGENT); }
DI unsigned xb_add(unsigned* p, unsigned v) { return __hip_atomic_fetch_add(p, v, __ATOMIC_RELAXED, __HIP_MEMORY_SCOPE_AGENT); }
DI unsigned xb_xcc_id() { return (unsigned)__builtin_amdgcn_s_getreg((3 << 11) | 20) & 0xFu; }
#define XB_SPIN(cond, bar)                                         \
  do {                                                             \
    unsigned _sp = 0;                                              \
    while (cond) {                                                 \
      __builtin_amdgcn_s_sleep(1);                                 \
      if ((++_sp & 255u) == 0u) {                                  \
        if (xb_ld(&(bar)[XB_TMO])) break;                          \
        if (_sp > XB_SPIN_CAP) {                                   \
          atomicAdd(&(bar)[XB_TMO], 1u);                           \
          break;                                                   \
        }                                                          \
      }                                                            \
    }                                                              \
  } while (0)
struct XcdBarrier {
  unsigned* bar;
  unsigned x;
  volatile LAS unsigned* st;
};
DI XcdBarrier xcd_barrier_post(unsigned* bar, volatile LAS unsigned* st) {
  XcdBarrier b;
  b.bar = bar;
  b.x = xb_xcc_id();
  b.st = st;
  if (threadIdx.x == 0) (void)xb_add(&bar[XB_XCNT(b.x)], 1u);
  return b;
}
DI void xcd_barrier_complete(unsigned* bar, unsigned x, unsigned& nloc, unsigned& nx) {
  const unsigned G = gridDim.x * gridDim.y * gridDim.z;
  unsigned sum, cnt, mine, sp = 0u;
  for (;;) {
    sum = 0u;
    cnt = 0u;
    mine = 0u;
#pragma unroll
    for (unsigned j = 0; j < 16; ++j) {
      const unsigned c = xb_ld(&bar[XB_XCNT(j)]);
      sum += c;
      cnt += (c > 0u) ? 1u : 0u;
      mine = (j == x) ? c : mine;
    }
    if (sum == G) break;
    __builtin_amdgcn_s_sleep(1);
    if ((++sp & 255u) == 0u) {
      if (xb_ld(&bar[XB_TMO])) break;
      if (sp > XB_SPIN_CAP) {
        atomicAdd(&bar[XB_TMO], 1u);
        break;
      }
    }
  }
  nloc = mine > 0u ? mine : 1u;
  nx = cnt > 0u ? cnt : 1u;
}
DI void xcd_barrier(const XcdBarrier& b) {
  asm volatile("s_waitcnt vmcnt(0)" ::: "memory");
  __syncthreads();
  if (threadIdx.x == 0) {
    unsigned* bar = b.bar;
    __builtin_amdgcn_s_waitcnt(0);
    unsigned nloc = b.st[0], nx = b.st[1];
    if (nloc == 0u) {
      xcd_barrier_complete(bar, b.x, nloc, nx);
      b.st[0] = nloc;
      b.st[1] = nx;
    }
    const unsigned old = xb_add(&bar[XB_XSUB(b.x)], 1u);
    const unsigned gen = old / nloc;
    if (old + 1u == (gen + 1u) * nloc) {
      __builtin_amdgcn_fence(__ATOMIC_RELEASE, "agent");
      asm volatile("s_waitcnt vmcnt(0)" ::: "memory");
      const unsigned og = xb_add(&bar[XB_TOP], 1u);
      const unsigned tg = og / nx;
      if (og + 1u == (tg + 1u) * nx) xb_add(&bar[XB_TOPGEN], 1u);
      else XB_SPIN(xb_ld(&bar[XB_TOPGEN]) == tg, bar);
      __builtin_amdgcn_fence(__ATOMIC_ACQUIRE, "agent");
      xb_add(&bar[XB_XGEN(b.x)], 1u);
      asm volatile("s_waitcnt vmcnt(0)" ::: "memory");
    } else {
      XB_SPIN(xb_ld(&bar[XB_XGEN(b.x)]) == gen, bar);
      __builtin_amdgcn_fence(__ATOMIC_ACQUIRE, "agent");
      asm volatile("s_waitcnt vmcnt(0)" ::: "memory");
    }
  }
  __syncthreads();
}

__device__ void run_phase(const Params& p, int ph, int bid, int nb, char* smem) {
  if (ph == 0) {
    phase_prep(p, bid, nb, smem);
    return;
  }
  int layer, sub;
  if (ph <= 4) { layer = 0; sub = ph - 1; }
  else if (ph <= 11) { layer = 1; sub = ph - 5; }
  else if (ph <= 15) { layer = 2; sub = ph - 12; }
  else { layer = 3; sub = ph - 16; }
  if ((layer & 1) == 0) {
    if (sub == 0) phase_norm(p, layer, bid, nb);
    else if (sub == 1) phase_gemm_in(p, layer, bid, nb, smem);
    else if (sub == 2) phase_even_mix(p, layer, bid, nb, smem);
    else phase_gemm_out(p, layer, bid, nb, smem);
  } else {
    if (sub == 0) phase_norm(p, layer, bid, nb);
    else if (sub == 1) phase_gemm_in(p, layer, bid, nb, smem);
    else if (sub == 2) phase_odd3(p, layer, bid, nb, smem);
    else if (sub == 3) phase_odd3b(p, layer, bid, nb, smem);
    else if (sub == 4) phase_odd4(p, layer, bid, nb, smem);
    else if (sub == 5) phase_odd5(p, layer, bid, nb, smem);
    else phase_gemm_out(p, layer, bid, nb, smem);
  }
}

#if !MEGA
__global__ void __launch_bounds__(256, 2) k_phase(Params p, int ph) {
  __shared__ __attribute__((aligned(16))) char smem[SMEM_BYTES];
  run_phase(p, ph, blockIdx.x, gridDim.x, smem);
}
#else
__global__ void __launch_bounds__(256, 2) k_mega(Params p) {
  __shared__ __attribute__((aligned(16))) char smem[SMEM_BYTES];
  cg::grid_group grid = cg::this_grid();
#ifdef __HIP_DEVICE_COMPILE__
  __shared__ uint4 xb_words;
  if (threadIdx.x == 0) xb_words = make_uint4(0u, 0u, 0u, 0u);
  __syncthreads();
  if (p.ws == nullptr) grid.sync();
  const XcdBarrier xb = xcd_barrier_post((unsigned*)(p.ws + OFF_BAR), (volatile LAS unsigned*)&xb_words);
  typedef const Params __attribute__((address_space(4))) * CPP;
  int ph = 0;
#ifdef PROBE_PH
  int rep = 0;
#endif
  while (ph < NPHASE) {
    CPP q = (CPP)__builtin_amdgcn_kernarg_segment_ptr();
    asm volatile("" : "+s"(q));
    const Params lp = *q;
    run_phase(lp, ph, blockIdx.x, gridDim.x, smem);
#ifdef PROBE_PH
    if (ph == PROBE_PH && rep < PROBE_REP) {
      ++rep;
      --ph;
    }
#endif
    ++ph;
    if (ph < NPHASE) {
      xcd_barrier(xb);
    }
  }
#endif
}
#endif

extern "C" void kernel_launch(void* const* d_in, const int* in_sizes, int n_in, void* d_out, int out_size, void* d_ws,
                              size_t ws_size, hipStream_t stream) {
  Params p{};
  const float** pp = (const float**)&p;
  for (int i = 0; i < 33; ++i) pp[i] = (const float*)d_in[i];
  p.out = (float*)d_out;
  p.ws = (char*)d_ws;
  if (ws_size < WS_TOTAL) fprintf(stderr, "workspace too small: %zu < %zu\n", ws_size, (size_t)WS_TOTAL);
  (void)hipMemsetAsync((char*)d_ws + OFF_MODS, 0, OFF_BAR + SZ_BAR, stream);
#if MEGA
  static int grid_blocks = 0;
  if (!grid_blocks) {
    int dev = 0, cus = 0, per_cu = 0;
    hipGetDevice(&dev);
    hipDeviceGetAttribute(&cus, hipDeviceAttributeMultiprocessorCount, dev);
    hipOccupancyMaxActiveBlocksPerMultiprocessor(&per_cu, k_mega, 256, 0);
    if (per_cu > 2) per_cu = 2;
    grid_blocks = cus * per_cu;
  }
  void* args[] = {&p};
  hipError_t e = hipLaunchCooperativeKernel((void*)k_mega, dim3(grid_blocks), dim3(256), args, 0, stream);
  if (e != hipSuccess) fprintf(stderr, "cooperative launch failed: %s (grid %d)\n", hipGetErrorString(e), grid_blocks);
#else
  for (int ph = 0; ph < NPHASE; ++ph) k_phase<<<1024, 256, 0, stream>>>(p, ph);
#endif
}
```
